# Optimizing an MI355X kernel written in HIP

```python
import math
import jax, jax.numpy as jnp
from jax import lax
import numpy as np

D_MODEL = 1024
BATCH = 8
SEQ = 2048
DEPTH = 4

GRID_W = 64
CTX_LEN = 256
N_MIXERS = 3
N_NA = len(range(0, DEPTH, N_MIXERS))
N_LRU = len(range(1, DEPTH, N_MIXERS))
N_SC = len(range(2, DEPTH, N_MIXERS))
NA_HEADS = 16
NA_HEAD_DIM = D_MODEL // NA_HEADS
WIN_ROWS = 8
WIN_COLS = 16
D_RNN = 128 * ((4 * D_MODEL // 3 + 64) // 128)
LRU_BLOCKS = 16
LRU_BLOCK_W = D_RNN // LRU_BLOCKS
LRU_CONV_W = 4
LRU_C = 8.0
SC_CONV_W = 3
D_FF = 256 * ((8 * D_MODEL // 3 + 128) // 256)
N_MOD = 9
ALPHA = (2 * DEPTH) ** 0.25
BETA = (8 * DEPTH) ** -0.25
LN_EPS = 1e-5
NEG_INF = -1e30

kernel_name = "hybrid_na_rglru_shortconv_prefix_dit"


def layer_norm(x, g, b):
    xf = x.astype(jnp.float32)
    mu = xf.mean(-1, keepdims=True)
    var = jnp.square(xf - mu).mean(-1, keepdims=True)
    return ((xf - mu) * lax.rsqrt(var + LN_EPS)).astype(x.dtype) * g + b


def modulation(cond, w, b):
    m = jax.nn.silu(cond) @ w + b
    return m.reshape(cond.shape[0], N_MOD, 1, D_MODEL)


def modulate(t, m, j):
    return t * (1 + m[:, 3 * j + 1]) + m[:, 3 * j]


def post_norm(t, m, j, y, g, b):
    return layer_norm(ALPHA * t + m[:, 3 * j + 2] * y, g, b)


def swiglu(h, w_in, w_out):
    g, u = jnp.split(h @ w_in, 2, axis=-1)
    return (jax.nn.silu(g) * u) @ w_out


def ffn_half(t, m, j, w_in, w_out, g, b):
    return post_norm(t, m, j, 0.5 * swiglu(modulate(t, m, j), w_in, w_out), g, b)


def dwconv_centred(u, w):
    k = w.shape[0]
    left = k // 2
    right = k - 1 - left
    return lax.conv_general_dilated(
        u, w[:, None, :].astype(u.dtype), window_strides=(1,), padding=[(left, right)],
        dimension_numbers=('NWC', 'WIO', 'NWC'), feature_group_count=u.shape[-1])


def na_mixer(h, hc, w_qkv, w_o, rpb, need_ctx):
    B, S, _ = h.shape
    L = hc.shape[1]
    rows = S // GRID_W
    kr = min(WIN_ROWS, rows)
    scale = NA_HEAD_DIM ** -0.5
    grid = (B, rows, GRID_W, NA_HEADS, NA_HEAD_DIM)
    q, k, v = [t.reshape(grid) for t in jnp.split(h @ w_qkv, 3, axis=-1)]
    kc, vc = [t.reshape(B, L, NA_HEADS, NA_HEAD_DIM) for t in jnp.split(hc @ w_qkv[:, D_MODEL:], 2, axis=-1)]

    col = jnp.arange(GRID_W)
    col_start = jnp.clip(col - WIN_COLS // 2, 0, GRID_W - WIN_COLS)
    kcol = col[None, :]
    col_in = (kcol >= col_start[:, None]) & (kcol < col_start[:, None] + WIN_COLS)
    dcol_idx = jnp.clip(kcol - col[:, None], 1 - WIN_COLS, WIN_COLS - 1) + WIN_COLS - 1

    def row_block(r):
        r0 = jnp.clip(r - kr // 2, 0, rows - kr)
        kb = lax.dynamic_slice_in_dim(k, r0, kr, axis=1)
        vb = lax.dynamic_slice_in_dim(v, r0, kr, axis=1)
        qr = lax.dynamic_index_in_dim(q, r, axis=1, keepdims=False)
        drow_idx = r0 + jnp.arange(kr) - r + WIN_ROWS - 1
        bias = rpb[:, drow_idx[None, :, None], dcol_idx[:, None, :]].astype(jnp.float32)
        s_loc = jnp.einsum('bqhd,bjkhd->bhqjk', qr, kb).astype(jnp.float32) * scale + bias
        s_loc = jnp.where(col_in[:, None, :], s_loc, NEG_INF)
        s_ctx = jnp.einsum('bqhd,blhd->bhql', qr, kc).astype(jnp.float32) * scale
        s = jnp.concatenate([s_loc.reshape(B, NA_HEADS, GRID_W, kr * GRID_W), s_ctx], axis=-1)
        p = jax.nn.softmax(s, axis=-1).astype(vb.dtype)
        p_loc = p[..., :kr * GRID_W].reshape(B, NA_HEADS, GRID_W, kr, GRID_W)
        p_ctx = p[..., kr * GRID_W:]
        return (jnp.einsum('bhqjk,bjkhd->bqhd', p_loc, vb)
                + jnp.einsum('bhql,blhd->bqhd', p_ctx, vc))

    o = lax.map(row_block, jnp.arange(rows))
    y = jnp.moveaxis(o, 0, 1).reshape(B, S, D_MODEL) @ w_o
    yc = None
    if need_ctx:
        qc = (hc @ w_qkv[:, :D_MODEL]).reshape(B, L, NA_HEADS, NA_HEAD_DIM)
        sc = jnp.einsum('bqhd,bkhd->bhqk', qc, kc).astype(jnp.float32) * scale
        pc = jax.nn.softmax(sc, axis=-1).astype(vc.dtype)
        yc = jnp.einsum('bhqk,bkhd->bqhd', pc, vc).reshape(B, L, D_MODEL) @ w_o
    return y, yc


def rglru_coeffs(u, w_g, b_g, lam):
    B, T, _ = u.shape
    ub = u.reshape(B, T, LRU_BLOCKS, LRU_BLOCK_W)
    gates = jnp.einsum('btnk,gnkj->gbtnj', ub, w_g).reshape(2, B, T, D_RNN) + b_g[:, None, None]
    gates = gates.astype(jnp.float32)
    r = jax.nn.sigmoid(gates[0])
    i = jax.nn.sigmoid(gates[1])
    log_a = -LRU_C * r * jax.nn.softplus(-lam.astype(jnp.float32))
    a = jnp.exp(log_a)
    b = jnp.sqrt(-jnp.expm1(2 * log_a)) * (i * u.astype(jnp.float32))
    return a, b


def linear_scan(a, b, reverse):
    def combine(e1, e2):
        a1, b1 = e1
        a2, b2 = e2
        return a1 * a2, a2 * b1 + b2
    return lax.associative_scan(combine, (a, b), axis=1, reverse=reverse)


def lru_mixer(h, hc, w_in, conv_w, conv_b, w_g, b_g, lam, w_out, need_ctx):
    gate_l, u_l = jnp.split(h @ w_in, 2, axis=-1)
    u_l = dwconv_centred(u_l, conv_w) + conv_b
    if need_ctx:
        gate_c, u_c = jnp.split(hc @ w_in, 2, axis=-1)
    else:
        u_c = hc @ w_in[:, D_RNN:]
    u_c = dwconv_centred(u_c, conv_w) + conv_b
    ys_l = []
    ys_c = []
    for d, rev in enumerate((False, True)):
        a_c, b_c = rglru_coeffs(u_c, w_g[d], b_g[d], lam[d])
        _, h_c = linear_scan(a_c, b_c, rev)
        h0 = h_c[:, 0] if rev else h_c[:, -1]
        a_l, b_l = rglru_coeffs(u_l, w_g[d], b_g[d], lam[d])
        a_cum, h_l = linear_scan(a_l, b_l, rev)
        ys_l.append(h_l + a_cum * h0[:, None])
        if need_ctx:
            ys_c.append(h_c)
    y = (jax.nn.gelu(gate_l) * (ys_l[0] + ys_l[1]).astype(h.dtype)) @ w_out
    yc = None
    if need_ctx:
        yc = (jax.nn.gelu(gate_c) * (ys_c[0] + ys_c[1]).astype(hc.dtype)) @ w_out
    return y, yc


def sc_mixer(h, hc, w_in, conv_w, w_out, need_ctx):
    def one(t):
        bg, cg, u = jnp.split(t @ w_in, 3, axis=-1)
        return (bg * dwconv_centred(cg * u, conv_w)) @ w_out
    return one(h), (one(hc) if need_ctx else None)


def setup_inputs(seed: int = 0) -> dict:
    key = jax.random.key(seed)
    ks = jax.random.split(key, 24)
    f32 = jnp.float32

    def nrm(k, shape, scale):
        return jax.random.normal(k, shape, f32) * scale

    a_pow = jax.random.uniform(ks[18], (N_LRU, 2, D_RNN), f32, 0.9, 0.999)
    a_base = a_pow ** (1.0 / LRU_C)
    return {
        "x": nrm(ks[0], (BATCH, SEQ, D_MODEL), 1.0),
        "c": nrm(ks[1], (BATCH, D_MODEL), 1.0),
        "ctx": nrm(ks[2], (BATCH, CTX_LEN, D_MODEL), 1.0),
        "c_ctx": nrm(ks[3], (D_MODEL,), 1.0),
        "mod_w": nrm(ks[4], (DEPTH, D_MODEL, N_MOD * D_MODEL), 0.5 * D_MODEL ** -0.5),
        "mod_b": nrm(ks[5], (DEPTH, N_MOD * D_MODEL), 0.02),
        "ln_g": 1.0 + nrm(ks[6], (DEPTH, 3, D_MODEL), 0.02),
        "ln_b": nrm(ks[7], (DEPTH, 3, D_MODEL), 0.02),
        "ffn_w_in": nrm(ks[8], (DEPTH, 2, D_MODEL, 2 * D_FF), D_MODEL ** -0.5),
        "ffn_w_out": nrm(ks[9], (DEPTH, 2, D_FF, D_MODEL), BETA * D_FF ** -0.5),
        "na_w_qkv": nrm(ks[10], (N_NA, D_MODEL, 3 * D_MODEL), D_MODEL ** -0.5),
        "na_w_o": nrm(ks[11], (N_NA, D_MODEL, D_MODEL), BETA * D_MODEL ** -0.5),
        "na_rpb": nrm(ks[12], (N_NA, NA_HEADS, 2 * WIN_ROWS - 1, 2 * WIN_COLS - 1), 0.1),
        "lru_w_in": nrm(ks[13], (N_LRU, D_MODEL, 2 * D_RNN), D_MODEL ** -0.5),
        "lru_conv_w": nrm(ks[14], (N_LRU, LRU_CONV_W, D_RNN), LRU_CONV_W ** -0.5),
        "lru_conv_b": nrm(ks[15], (N_LRU, D_RNN), 0.02),
        "lru_w_gates": nrm(ks[16], (N_LRU, 2, 2, LRU_BLOCKS, LRU_BLOCK_W, LRU_BLOCK_W), LRU_BLOCK_W ** -0.5),
        "lru_b_gates": nrm(ks[17], (N_LRU, 2, 2, D_RNN), 0.02),
        "lru_lambda": jnp.log(a_base) - jnp.log1p(-a_base),
        "lru_w_out": nrm(ks[19], (N_LRU, D_RNN, D_MODEL), BETA * D_RNN ** -0.5),
        "sc_w_in": nrm(ks[20], (N_SC, D_MODEL, 3 * D_MODEL), D_MODEL ** -0.5),
        "sc_conv_w": nrm(ks[21], (N_SC, SC_CONV_W, D_MODEL), SC_CONV_W ** -0.5),
        "sc_w_out": nrm(ks[22], (N_SC, D_MODEL, D_MODEL), BETA * D_MODEL ** -0.5),
    }


def reference(x, c, ctx, c_ctx, mod_w, mod_b, ln_g, ln_b, ffn_w_in, ffn_w_out, na_w_qkv, na_w_o, na_rpb,
              lru_w_in, lru_conv_w, lru_conv_b, lru_w_gates, lru_b_gates, lru_lambda, lru_w_out,
              sc_w_in, sc_conv_w, sc_w_out):
    xc = ctx
    for l in range(DEPTH):
        kind = l % N_MIXERS
        idx = l // N_MIXERS
        ctx_out = l < DEPTH - 1
        ctx_in = ctx_out or kind != 2
        m = modulation(c, mod_w[l], mod_b[l])
        mc = modulation(c_ctx[None], mod_w[l], mod_b[l]) if ctx_in else None

        x = ffn_half(x, m, 0, ffn_w_in[l, 0], ffn_w_out[l, 0], ln_g[l, 0], ln_b[l, 0])
        if ctx_in:
            xc = ffn_half(xc, mc, 0, ffn_w_in[l, 0], ffn_w_out[l, 0], ln_g[l, 0], ln_b[l, 0])

        h = modulate(x, m, 1)
        hc = modulate(xc, mc, 1) if ctx_in else None
        if kind == 0:
            y, yc = na_mixer(h, hc, na_w_qkv[idx], na_w_o[idx], na_rpb[idx], ctx_out)
        elif kind == 1:
            y, yc = lru_mixer(h, hc, lru_w_in[idx], lru_conv_w[idx], lru_conv_b[idx], lru_w_gates[idx],
                              lru_b_gates[idx], lru_lambda[idx], lru_w_out[idx], ctx_out)
        else:
            y, yc = sc_mixer(h, hc, sc_w_in[idx], sc_conv_w[idx], sc_w_out[idx], ctx_out)
        x = post_norm(x, m, 1, y, ln_g[l, 1], ln_b[l, 1])

        x = ffn_half(x, m, 2, ffn_w_in[l, 1], ffn_w_out[l, 1], ln_g[l, 2], ln_b[l, 2])
        if ctx_out:
            xc = post_norm(xc, mc, 1, yc, ln_g[l, 1], ln_b[l, 1])
            xc = ffn_half(xc, mc, 2, ffn_w_in[l, 1], ffn_w_out[l, 1], ln_g[l, 2], ln_b[l, 2])
    return x
```

```cpp
#include <hip/hip_runtime.h>
#include <hip/hip_cooperative_groups.h>
#include <cstdio>
#include <cstdint>
namespace cg = cooperative_groups;
namespace pg8 {
#define PG8_LAS __attribute__((address_space(3)))
typedef unsigned short bf16_t;
typedef short bf16x8 __attribute__((ext_vector_type(8)));
typedef float f32x4 __attribute__((ext_vector_type(4)));
typedef unsigned u32x4 __attribute__((ext_vector_type(4)));
constexpr int BM = 256, BK = 64, HALF = 128, HTB = HALF * BK * 2  , STAGE_BYTES = 8 * HTB, NXCD = 8, WGM = 8;

__host__ __device__ __forceinline__ int lds_byte(int r, int c) { const int st = (r >> 4) * 2 + (c >> 5), rr = r & 15, cc = c & 31, ob = rr * 64 + cc * 2; return st * 1024 + (ob ^ (((ob >> 9) & 1) << 5)); }
__host__ __device__ __forceinline__ void stage_rc(int b, int& R, int& C) { const int st = b / 1024, sb = b % 1024, swz = sb ^ (((sb >> 9) & 1) << 5); R = (st >> 1) * 16 + swz / 64; C = (st & 1) * 32 + (swz % 64) / 2; }
__host__ __device__ __forceinline__ int perm32(int rho) { const int n = rho >> 4, i = rho & 15; return 8 * (i >> 2) + 4 * n + (i & 3); }

struct Unit { int pm, pn; };
struct Gemm { const bf16_t* A; const bf16_t* Bt; int M, N, K; };

struct StaticOrder {
    int nM, nN, nwg, G, c;
    __host__ __device__ void init(int M, int N, int G_, int c_) { nM = M / BM; nN = N / BM; nwg = nM * nN; G = G_; c = c_; }
    __host__ __device__ bool next(int i, Unit& u) const {
        const long L = (long)i * G + c; if (L >= nwg) return false;
        int wgid = (int)L; { const int q = nwg / NXCD, r = nwg % NXCD, xcd = wgid % NXCD, off = wgid / NXCD; wgid = (xcd < r ? xcd * (q + 1) : r * (q + 1) + (xcd - r) * q) + off; }
        const int nig = WGM * nN, gid = wgid / nig, fm = gid * WGM, gsz = (nM - fm) < WGM ? (nM - fm) : WGM;
        u.pm = fm + ((wgid % nig) % gsz); u.pn = (wgid % nig) / gsz; return true;
    }
    __device__ __forceinline__ void a_ready(const Unit&) const {}
    __device__ __forceinline__ void done(const Unit&) const {}
};

__device__ __forceinline__ unsigned cvt_pk_bf16(float lo, float hi) { unsigned r; asm volatile("v_cvt_pk_bf16_f32 %0, %1, %2" : "=v"(r) : "v"(lo), "v"(hi)); return r; }
typedef float f32x2 __attribute__((ext_vector_type(2)));
typedef unsigned u32x2 __attribute__((ext_vector_type(2)));
__device__ __forceinline__ float fast_sigmoid(float v) { return __builtin_amdgcn_rcpf(1.0f + __expf(-v)); }
__device__ __forceinline__ float silu_f(float v) { return v * fast_sigmoid(v); }
__device__ __forceinline__ float gelu_tanh_f(float v) { const float y = 0.7978845608028654f * (v + 0.044715f * v * v * v); return v * fast_sigmoid(2.0f * y); }

struct EpiPair {
    static constexpr bool PERM = true, AFTER_DRAIN = false;
    bf16_t* O0; bf16_t* O1; int ld0, ld1; int mode;
    __device__ __forceinline__ void operator()(const f32x4 (&acc)[2][2][4][2], const Unit& u, int wr, int wc, int fr, int fq) const {
        if (mode == 0) body<0>(acc, u, wr, wc, fr, fq); else body<1>(acc, u, wr, wc, fr, fq);
    }
    template <int MODE> __device__ __forceinline__ void body(const f32x4 (&acc)[2][2][4][2], const Unit& u, int wr, int wc, int fr, int fq) const {
        const int row0 = u.pm * BM + wr * 64 + fr;
        if (MODE == 1 && u.pn < 4) {
            const int col0 = u.pn * BM + wc * 32 + 8 * fq;
#pragma unroll
            for (int ai = 0; ai < 2; ++ai)
#pragma unroll
                for (int m = 0; m < 4; ++m) { bf16_t* rowp = O0 + (size_t)(row0 + ai * HALF + m * 16) * ld0 + col0;
#pragma unroll
                    for (int bj = 0; bj < 2; ++bj) { const f32x4 v0 = acc[ai][bj][m][0], v1 = acc[ai][bj][m][1];
                        u32x4 w; w.x = cvt_pk_bf16(v0[0], v0[1]); w.y = cvt_pk_bf16(v0[2], v0[3]); w.z = cvt_pk_bf16(v1[0], v1[1]); w.w = cvt_pk_bf16(v1[2], v1[3]);
                        *(u32x4*)(rowp + bj * HALF) = w; } }
        } else {
            const int pnn = (MODE == 1) ? (u.pn - 4) : u.pn;
            bf16_t* O = (MODE == 1) ? O1 : O0; const int ld = (MODE == 1) ? ld1 : ld0;
            const int col0 = pnn * HALF + wc * 32 + 8 * fq;
#pragma unroll
            for (int ai = 0; ai < 2; ++ai)
#pragma unroll
                for (int m = 0; m < 4; ++m) {
                    float r[8];
#pragma unroll
                    for (int n = 0; n < 2; ++n)
#pragma unroll
                        for (int j = 0; j < 4; ++j) { const float g = acc[ai][0][m][n][j], uu = acc[ai][1][m][n][j]; r[n * 4 + j] = (MODE == 0) ? silu_f(g) * uu : g * uu; }
                    u32x4 w; w.x = cvt_pk_bf16(r[0], r[1]); w.y = cvt_pk_bf16(r[2], r[3]); w.z = cvt_pk_bf16(r[4], r[5]); w.w = cvt_pk_bf16(r[6], r[7]);
                    *(u32x4*)(O + (size_t)(row0 + ai * HALF + m * 16) * ld + col0) = w; }
        }
    }
};
struct EpiSplit {
    static constexpr bool PERM = true, AFTER_DRAIN = false;
    bf16_t* O0; bf16_t* O1; int split, ld0, ld1; int act;
    __device__ __forceinline__ void operator()(const f32x4 (&acc)[2][2][4][2], const Unit& u, int wr, int wc, int fr, int fq) const {
        if (act == 0) body<0>(acc, u, wr, wc, fr, fq); else body<1>(acc, u, wr, wc, fr, fq);
    }
    template <int ACT> __device__ __forceinline__ void body(const f32x4 (&acc)[2][2][4][2], const Unit& u, int wr, int wc, int fr, int fq) const {
        const int row0 = u.pm * BM + wr * 64 + fr;
#pragma unroll
        for (int bj = 0; bj < 2; ++bj) {
            const int cb = u.pn * BM + bj * HALF; const bool second = cb >= split;
            bf16_t* O = second ? O1 : O0; const int ld = second ? ld1 : ld0; const int col0 = (second ? cb - split : cb) + wc * 32 + 8 * fq;
#pragma unroll
            for (int ai = 0; ai < 2; ++ai)
#pragma unroll
                for (int m = 0; m < 4; ++m) { f32x4 v0 = acc[ai][bj][m][0], v1 = acc[ai][bj][m][1];
                    if (ACT == 1 && !second) {
#pragma unroll
                        for (int j = 0; j < 4; ++j) { v0[j] = gelu_tanh_f(v0[j]); v1[j] = gelu_tanh_f(v1[j]); } }
                    u32x4 w; w.x = cvt_pk_bf16(v0[0], v0[1]); w.y = cvt_pk_bf16(v0[2], v0[3]); w.z = cvt_pk_bf16(v1[0], v1[1]); w.w = cvt_pk_bf16(v1[2], v1[3]);
                    *(u32x4*)(O + (size_t)(row0 + ai * HALF + m * 16) * ld + col0) = w; }
        }
    }
};
struct EpiRes {
    static constexpr bool PERM = false, AFTER_DRAIN = false;
    float* XZ; const float* gate; float cmul;
    __device__ __forceinline__ void operator()(const f32x4 (&acc)[2][2][4][2], const Unit& u, int wr, int wc, int fr, int fq) const {
        const int mi = (u.pm < 64) ? (u.pm >> 3) : 8;
        const int row0 = u.pm * BM + wr * 64 + fr, col0 = u.pn * BM + wc * 32 + 4 * fq;
        const float* gp = gate + (size_t)mi * 9216 + col0;
        f32x4 gv[2][2];
#pragma unroll
        for (int bj = 0; bj < 2; ++bj)
#pragma unroll
            for (int n = 0; n < 2; ++n) gv[bj][n] = *(const f32x4*)(gp + bj * HALF + n * 16) * cmul;
#pragma unroll
        for (int ai = 0; ai < 2; ++ai)
#pragma unroll
            for (int m = 0; m < 4; ++m) { float* rowp = XZ + (size_t)(row0 + ai * HALF + m * 16) * 1024 + col0;
#pragma unroll
                for (int bj = 0; bj < 2; ++bj)
#pragma unroll
                    for (int n = 0; n < 2; ++n) { const f32x4 xv = *(const f32x4*)(rowp + bj * HALF + n * 16);
                        *(f32x4*)(rowp + bj * HALF + n * 16) = xv * 1.6817928305074290f + gv[bj][n] * acc[ai][bj][m][n]; } }
    }
};
template <class Epi, class Sched, bool ALIGN_EPI = false, bool SP2 = false>
__device__ __forceinline__ void gemm_phase(PG8_LAS unsigned char* lds, const Gemm g, const Sched& S, const Epi& E) {
    int tidv = threadIdx.x; asm volatile("" : "+v"(tidv)); const int tid = tidv, wid = __builtin_amdgcn_readfirstlane(tid >> 6), lane = tid & 63, wr = wid >> 2, wc = wid & 3, fr = lane & 15, fq = lane >> 4;
    const int K = g.K, nt = K / BK;
    unsigned voffA[2], voffB[2];
#pragma unroll
    for (int i = 0; i < 2; ++i) { int R, C; stage_rc(tid * 16 + i * 8192, R, C); const int Rb = Epi::PERM ? ((R & ~31) + perm32(R & 31)) : R;
        voffA[i] = (unsigned)(R * K + C) * 2u; voffB[i] = (unsigned)(Rb * K + C) * 2u; }
    const size_t kstep = (size_t)(BK * 2);
    const size_t hstep = (size_t)HALF * K * 2;
    const size_t tstep = 2 * hstep;
    const unsigned ldsw = (unsigned)wid * 1024u;
    const int aoff = lds_byte(wr * 64 + fr, fq * 8), boff = lds_byte(wc * 32 + fr, fq * 8);
#define PG8_SA(b, h) (((b) * 2 + (h)) * HTB)
#define PG8_SB(b, h) ((4 + (b) * 2 + (h)) * HTB)
#define PG8_STAGE(bufoff, gbase, voff) do { _Pragma("unroll") for (int _i = 0; _i < 2; ++_i) \
        __builtin_amdgcn_global_load_lds((const unsigned*)((const char*)(gbase) + (voff)[_i]), (PG8_LAS unsigned*)(lds + (bufoff) + ldsw + _i * 8192), 16, 0, 0); } while (0)
#define PG8_LDA(dst, b, h) do { _Pragma("unroll") for (int m = 0; m < 4; ++m) _Pragma("unroll") for (int k = 0; k < 2; ++k) dst[m][k] = *(const PG8_LAS bf16x8*)(lds + PG8_SA(b, h) + aoff + m * 2048 + k * 1024); } while (0)
#define PG8_LDB(dst, b, h) do { _Pragma("unroll") for (int n = 0; n < 2; ++n) _Pragma("unroll") for (int k = 0; k < 2; ++k) dst[n][k] = *(const PG8_LAS bf16x8*)(lds + PG8_SB(b, h) + boff + n * 2048 + k * 1024); } while (0)
#define PG8_MMA(ai, bj, At, Bt) do { __builtin_amdgcn_s_setprio(1); _Pragma("unroll") for (int m = 0; m < 4; ++m) _Pragma("unroll") for (int n = 0; n < 2; ++n) _Pragma("unroll") for (int k = 0; k < 2; ++k) \
        acc[ai][bj][m][n] = __builtin_amdgcn_mfma_f32_16x16x32_bf16(Bt[n][k], At[m][k], acc[ai][bj][m][n], 0, 0, 0); __builtin_amdgcn_s_setprio(0); } while (0)
#define PG8_WAIT_V(n) asm volatile("s_waitcnt vmcnt(" #n ")" ::: "memory")
#define PG8_WAIT_L(n) asm volatile("s_waitcnt lgkmcnt(" #n ")" ::: "memory")
#define PG8_BAR __builtin_amdgcn_s_barrier()
#define PG8_SCHED __builtin_amdgcn_sched_barrier(0)
    Unit cur, nxt; int ui = 0;
    if (!S.next(0, cur)) return;
    f32x4 acc[2][2][4][2];
#pragma unroll
    for (int a = 0; a < 2; ++a)
#pragma unroll
        for (int b = 0; b < 2; ++b)
#pragma unroll
            for (int m = 0; m < 4; ++m)
#pragma unroll
                for (int n = 0; n < 2; ++n) acc[a][b][m][n] = (f32x4){0.f, 0.f, 0.f, 0.f};
    bf16x8 At[4][2], B0[2][2], B1[2][2];
    const char* cA = (const char*)g.A + (size_t)cur.pm * tstep; const char* cB = (const char*)g.Bt + (size_t)cur.pn * tstep;
    S.a_ready(cur);
    if constexpr (SP2) {
        PG8_STAGE(PG8_SB(0, 0), cB, voffB); PG8_STAGE(PG8_SB(0, 1), cB + hstep, voffB); PG8_STAGE(PG8_SA(0, 0), cA, voffA); PG8_STAGE(PG8_SA(0, 1), cA + hstep, voffA);
        if (wr == 1) PG8_BAR;
        PG8_WAIT_V(2); PG8_BAR;
        PG8_STAGE(PG8_SB(1, 0), cB + kstep, voffB); PG8_STAGE(PG8_SA(1, 0), cA + kstep, voffA); PG8_STAGE(PG8_SB(1, 1), cB + hstep + kstep, voffB);
        PG8_WAIT_V(6); PG8_BAR;
    } else {
        PG8_STAGE(PG8_SB(0, 0), cB, voffB); PG8_STAGE(PG8_SA(0, 0), cA, voffA); PG8_STAGE(PG8_SB(0, 1), cB + hstep, voffB); PG8_STAGE(PG8_SA(0, 1), cA + hstep, voffA);
        if (wr == 1) PG8_BAR;
        PG8_WAIT_V(4); PG8_BAR;
        PG8_STAGE(PG8_SB(1, 0), cB + kstep, voffB); PG8_STAGE(PG8_SA(1, 0), cA + kstep, voffA); PG8_STAGE(PG8_SB(1, 1), cB + hstep + kstep, voffB);
        PG8_WAIT_V(6); PG8_BAR;
    }
    for (;;) {
        const bool has_next = S.next(ui + 1, nxt);
        const char* nA = has_next ? (const char*)g.A + (size_t)nxt.pm * tstep : cA; const char* nB = has_next ? (const char*)g.Bt + (size_t)nxt.pn * tstep : cB;
        for (int t = 0; t < nt; t += 2) {
            const bool last = (t == nt - 2);
            const char* a1 = cA + (size_t)(t + 1) * kstep;
            const char* a2 = last ? nA : cA + (size_t)(t + 2) * kstep; const char* b2 = last ? nB : cB + (size_t)(t + 2) * kstep;
            const char* a3 = a2 + kstep; const char* b3 = b2 + kstep;
            if (last && has_next) S.a_ready(nxt);
            if constexpr (SP2) {
            PG8_LDB(B0, 0, 0); PG8_LDB(B1, 0, 1); PG8_SCHED; PG8_LDA(At, 0, 0); PG8_STAGE(PG8_SA(1, 1), a1 + hstep, voffA);
            PG8_WAIT_V(8); PG8_WAIT_L(0); PG8_BAR; PG8_MMA(0, 0, At, B0); PG8_MMA(0, 1, At, B1); PG8_BAR; PG8_SCHED;
            PG8_LDA(At, 0, 1); PG8_STAGE(PG8_SB(0, 0), b2, voffB); PG8_STAGE(PG8_SB(0, 1), b2 + hstep, voffB); PG8_STAGE(PG8_SA(0, 0), a2, voffA);
            PG8_WAIT_V(8); PG8_WAIT_L(0); PG8_BAR; PG8_MMA(1, 0, At, B0); PG8_MMA(1, 1, At, B1); PG8_BAR; PG8_SCHED;
            PG8_LDB(B0, 1, 0); PG8_LDB(B1, 1, 1); PG8_SCHED; PG8_LDA(At, 1, 0); PG8_STAGE(PG8_SA(0, 1), a2 + hstep, voffA);
            PG8_WAIT_V(8); PG8_WAIT_L(0); PG8_BAR; PG8_MMA(0, 0, At, B0); PG8_MMA(0, 1, At, B1); PG8_BAR; PG8_SCHED;
            PG8_LDA(At, 1, 1); PG8_STAGE(PG8_SB(1, 0), b3, voffB); PG8_STAGE(PG8_SB(1, 1), b3 + hstep, voffB); PG8_STAGE(PG8_SA(1, 0), a3, voffA);
            PG8_WAIT_V(8); PG8_WAIT_L(0); PG8_BAR; PG8_MMA(1, 0, At, B0); PG8_MMA(1, 1, At, B1); PG8_BAR; PG8_SCHED;
            } else {
            PG8_LDB(B0, 0, 0); PG8_SCHED; PG8_LDA(At, 0, 0); PG8_STAGE(PG8_SA(1, 1), a1 + hstep, voffA);
            PG8_WAIT_L(8); PG8_BAR; PG8_WAIT_L(0); PG8_MMA(0, 0, At, B0); PG8_BAR; PG8_SCHED;
            PG8_LDB(B1, 0, 1); PG8_STAGE(PG8_SB(0, 0), b2, voffB);
            PG8_BAR; PG8_WAIT_L(0); PG8_MMA(0, 1, At, B1); PG8_BAR;
            PG8_LDA(At, 0, 1); PG8_STAGE(PG8_SA(0, 0), a2, voffA);
            PG8_BAR; PG8_WAIT_L(0); PG8_MMA(1, 0, At, B0); PG8_BAR; PG8_SCHED;
            PG8_STAGE(PG8_SB(0, 1), b2 + hstep, voffB);
            PG8_WAIT_V(6); PG8_BAR; PG8_MMA(1, 1, At, B1); PG8_BAR;
            PG8_LDB(B0, 1, 0); PG8_SCHED; PG8_LDA(At, 1, 0); PG8_STAGE(PG8_SA(0, 1), a2 + hstep, voffA);
            PG8_WAIT_L(8); PG8_BAR; PG8_WAIT_L(0); PG8_MMA(0, 0, At, B0); PG8_BAR; PG8_SCHED;
            PG8_LDB(B1, 1, 1); PG8_STAGE(PG8_SB(1, 0), b3, voffB);
            PG8_BAR; PG8_WAIT_L(0); PG8_MMA(0, 1, At, B1); PG8_BAR;
            PG8_LDA(At, 1, 1); PG8_STAGE(PG8_SA(1, 0), a3, voffA);
            PG8_BAR; PG8_WAIT_L(0); PG8_MMA(1, 0, At, B0); PG8_BAR; PG8_SCHED;
            PG8_STAGE(PG8_SB(1, 1), b3 + hstep, voffB);
            PG8_WAIT_V(6); PG8_BAR; PG8_MMA(1, 1, At, B1); PG8_BAR;
            }
        }
        if constexpr (ALIGN_EPI) { if (wr == 0) PG8_BAR; }
        if constexpr (!Epi::AFTER_DRAIN) { E(acc, cur, wr, wc, fr, fq); S.done(cur); }
        if (!has_next) break;
#pragma unroll
        for (int a = 0; a < 2; ++a)
#pragma unroll
            for (int b = 0; b < 2; ++b)
#pragma unroll
                for (int m = 0; m < 4; ++m)
#pragma unroll
                    for (int n = 0; n < 2; ++n) acc[a][b][m][n] = (f32x4){0.f, 0.f, 0.f, 0.f};
        cur = nxt; cA = nA; cB = nB; ++ui;
        if constexpr (ALIGN_EPI) { if (wr == 1) PG8_BAR; }
    }
    PG8_WAIT_V(0);
    if constexpr (!ALIGN_EPI) { if (wr == 0) PG8_BAR; }
    PG8_BAR;
    if constexpr (Epi::AFTER_DRAIN) { E.fused(acc, cur, wr, wc, fr, fq, lds, wid, lane); S.done(cur); }
#undef PG8_SA
#undef PG8_SB
#undef PG8_STAGE
#undef PG8_LDA
#undef PG8_LDB
#undef PG8_MMA
#undef PG8_WAIT_V
#undef PG8_WAIT_L
#undef PG8_BAR
#undef PG8_SCHED
}
}

#define LAS __attribute__((address_space(3)))
using pg8::bf16_t; using pg8::bf16x8; using pg8::f32x4; using pg8::u32x4; using pg8::u32x2; using pg8::cvt_pk_bf16;

constexpr int NBATCH = 8, SEQ = 2048, CTXL = 256;
constexpr int ML = NBATCH * SEQ, MC = NBATCH * CTXL, MT = ML + MC;
constexpr int DFF = 2816, DRNN = 1408, MODLD = 9216;
constexpr int LDS_BYTES = 131072;
constexpr float LOG2E = 1.4426950408889634f;

struct Params {
    const float *x, *c, *ctx, *c_ctx, *mod_w, *mod_b, *ln_g, *ln_b, *ffn_w_in, *ffn_w_out, *na_w_qkv, *na_w_o, *na_rpb,
                *lru_w_in, *lru_conv_w, *lru_conv_b, *lru_wg, *lru_bg, *lru_lam, *lru_w_out, *sc_w_in, *sc_conv_w, *sc_w_out;
    float* out;
    unsigned char* ws;
};

constexpr size_t SZ_FFN_IN = (size_t)5632 * 1024 * 2, SZ_FFN_OUT = (size_t)1024 * 2816 * 2;
constexpr size_t OFF_W_FFN_IN = 0;
constexpr size_t OFF_W_FFN_OUT = OFF_W_FFN_IN + 8 * SZ_FFN_IN;
constexpr size_t OFF_W_QK = OFF_W_FFN_OUT + 8 * SZ_FFN_OUT;
constexpr size_t OFF_W_V = OFF_W_QK + 2 * (size_t)2048 * 1024 * 2;
constexpr size_t OFF_W_O = OFF_W_V + 2 * (size_t)1024 * 1024 * 2;
constexpr size_t OFF_W_LIN = OFF_W_O + 2 * (size_t)1024 * 1024 * 2;
constexpr size_t OFF_W_LOUT = OFF_W_LIN + (size_t)2816 * 1024 * 2;
constexpr size_t OFF_W_SIN = OFF_W_LOUT + (size_t)1024 * 1408 * 2;
constexpr size_t OFF_W_SOUT = OFF_W_SIN + (size_t)3072 * 1024 * 2;
constexpr size_t OFF_W_G = OFF_W_SOUT + (size_t)1024 * 1024 * 2;
constexpr size_t OFF_MOD = OFF_W_G + (size_t)16 * 384 * 96 * 2;
constexpr size_t OFF_XZ = OFF_MOD + (size_t)4 * 9 * 9216 * 4;
constexpr size_t OFF_H = OFF_XZ + (size_t)MT * 1024 * 4;
constexpr size_t OFF_ACT = OFF_H + (size_t)MT * 1024 * 2;
constexpr size_t OFF_UCONV = OFF_ACT + (size_t)MT * 3072 * 2;
constexpr size_t OFF_LAB = OFF_UCONV + (size_t)MT * 1408 * 2 + 256;
constexpr size_t WS_END = OFF_LAB + 4 * (size_t)MT * 1408 * 2 + 256;

__device__ __forceinline__ float bf2f(unsigned v) { return __uint_as_float(v << 16); }
__device__ __forceinline__ float bflo(unsigned v) { return __uint_as_float(v << 16); }
__device__ __forceinline__ float bfhi(unsigned v) { return __uint_as_float(v & 0xffff0000u); }
__device__ __forceinline__ bf16_t f2bf(float v) { return (bf16_t)(cvt_pk_bf16(v, 0.f) & 0xffffu); }
__device__ __forceinline__ float wave_sum(float v) {
#pragma unroll
    for (int o = 1; o < 64; o <<= 1) v += __shfl_xor(v, o);
    return v;
}
__device__ __forceinline__ f32x4 mfma16(bf16x8 a, bf16x8 b, f32x4 c) { return __builtin_amdgcn_mfma_f32_16x16x32_bf16(a, b, c, 0, 0, 0); }

__device__ __forceinline__ void conv_tile(const float* src, int ld, int col0, int K, int N, int base, int Hh, bf16_t* dst, int tile, LAS float* fl, int tid) {
    const int ntn = N >> 7, kb = tile / ntn, nb = tile - kb * ntn, k0 = kb * 64, n0 = nb * 128;
    int sc;
    if (n0 < base) sc = n0; else { const int q = n0 - base, pn = q >> 8, bj = (q >> 7) & 1; sc = base + bj * Hh + 128 * pn; }
    sc += col0;
    const int nn2 = (tid & 63) * 2;
#pragma unroll
    for (int i = 0; i < 8; ++i) { const int kk = (tid >> 6) + 8 * i; const float2 v = *(const float2*)(src + (size_t)(k0 + kk) * ld + sc + nn2); fl[kk * 129 + nn2] = v.x; fl[kk * 129 + nn2 + 1] = v.y; }
    __syncthreads();
    const int kk2 = 2 * (tid & 31);
#pragma unroll
    for (int i = 0; i < 8; ++i) { const int nn = (tid >> 5) + 16 * i; const unsigned w = cvt_pk_bf16(fl[kk2 * 129 + nn], fl[(kk2 + 1) * 129 + nn]); *(unsigned*)(dst + (size_t)(n0 + nn) * K + k0 + kk2) = w; }
    __syncthreads();
}

__device__ __forceinline__ void ln_phase(float* XZ, bf16_t* H, float* out, const float* g, const float* b, const float* modn, bool is_final, int Mrows, int gw, int ngw, int lane) {
    for (int row = gw; row < Mrows; row += ngw) {
        const f32x4* zr = (const f32x4*)(XZ + (size_t)row * 1024) + lane;
        f32x4 v[4]; float s = 0.f;
#pragma unroll
        for (int j = 0; j < 4; ++j) { v[j] = zr[64 * j]; s += (v[j][0] + v[j][1]) + (v[j][2] + v[j][3]); }
        const float mean = wave_sum(s) * (1.0f / 1024.0f); float s2 = 0.f;
#pragma unroll
        for (int j = 0; j < 4; ++j) { v[j] = v[j] - mean; s2 += (v[j][0] * v[j][0] + v[j][1] * v[j][1]) + (v[j][2] * v[j][2] + v[j][3] * v[j][3]); }
        const float rstd = 1.0f / sqrtf(wave_sum(s2) * (1.0f / 1024.0f) + 1e-5f);
        const int mi = row < ML ? (row >> 11) : 8;
#pragma unroll
        for (int j = 0; j < 4; ++j) {
            const int col = 256 * j + 4 * lane;
            const f32x4 gg = *(const f32x4*)(g + col), bb = *(const f32x4*)(b + col);
            const f32x4 xv = v[j] * rstd * gg + bb;
            if (is_final) { *(f32x4*)(out + (size_t)row * 1024 + col) = xv; }
            else {
                *(f32x4*)(XZ + (size_t)row * 1024 + col) = xv;
                const f32x4 sh = *(const f32x4*)(modn + (size_t)mi * MODLD + col), sc = *(const f32x4*)(modn + (size_t)mi * MODLD + 1024 + col);
                const f32x4 hv = xv * (sc + 1.0f) + sh;
                u32x2 w; w.x = cvt_pk_bf16(hv[0], hv[1]); w.y = cvt_pk_bf16(hv[2], hv[3]);
                *(u32x2*)(H + (size_t)row * 1024 + col) = w;
            }
        }
    }
}

__device__ __forceinline__ void attn_phase(const bf16_t* QK, const bf16_t* VT, bf16_t* O, const float* rpb, bool need_ctx, LAS float* btab, int gw, int ngw, int lane) {
    const int fr = lane & 15, fq = lane >> 4;
    const int nunits = 4096 + (need_ctx ? 512 : 0);
    const float SC2 = 0.125f * LOG2E;
    for (int u = gw; u < nunits; u += ngw) {
        int b, h, r, r0, tq0, nloc;
        if (u < 4096) { r = u & 31; h = (u >> 5) & 15; b = u >> 9; r0 = min(max(r - 4, 0), 24); tq0 = b * SEQ + r * 64; nloc = 16; }
        else { const int v = u - 4096; const int qc4 = v & 3; h = (v >> 2) & 15; b = v >> 6; r = 0; r0 = 0; tq0 = ML + b * CTXL + qc4 * 64; nloc = 0; }
        const int tk0 = b * SEQ + r0 * 64, tc0 = ML + b * CTXL;
        asm volatile("s_waitcnt lgkmcnt(0)" ::: "memory");
        for (int i = lane; i < 465; i += 64) btab[i] = rpb[h * 465 + i] * LOG2E;
        asm volatile("s_waitcnt lgkmcnt(0)" ::: "memory");
        bf16x8 bq[4][2];
#pragma unroll
        for (int qt = 0; qt < 4; ++qt)
#pragma unroll
            for (int ks = 0; ks < 2; ++ks) bq[qt][ks] = *(const bf16x8*)(QK + (size_t)(tq0 + 16 * qt + fr) * 2048 + h * 64 + 32 * ks + 8 * fq);
        f32x4 oacc[4][4];
#pragma unroll
        for (int dt = 0; dt < 4; ++dt)
#pragma unroll
            for (int qt = 0; qt < 4; ++qt) oacc[dt][qt] = (f32x4){0.f, 0.f, 0.f, 0.f};
        float mrun[4], lsum[4];
#pragma unroll
        for (int qt = 0; qt < 4; ++qt) { mrun[qt] = -1e29f; lsum[qt] = 0.f; }
        const int nsteps = nloc + 8;
        for (int s = 0; s < nsteps; ++s) {
            const bool loc = s < nloc;
            const int kt = loc ? tk0 + 32 * s : tc0 + 32 * (s - nloc);
            bf16x8 ak[2][2];
#pragma unroll
            for (int kt2 = 0; kt2 < 2; ++kt2)
#pragma unroll
                for (int ks = 0; ks < 2; ++ks) ak[kt2][ks] = *(const bf16x8*)(QK + (size_t)(kt + 16 * kt2 + fr) * 2048 + 1024 + h * 64 + 32 * ks + 8 * fq);
            bf16x8 av[4];
#pragma unroll
            for (int dt = 0; dt < 4; ++dt) { const bf16_t* vp = VT + (size_t)(h * 64 + 16 * dt + fr) * MT + kt + 4 * fq;
                const u32x2 lo = *(const u32x2*)vp, hi = *(const u32x2*)(vp + 16); u32x4 t4; t4.x = lo.x; t4.y = lo.y; t4.z = hi.x; t4.w = hi.y; av[dt] = __builtin_bit_cast(bf16x8, t4); }
            f32x4 sacc[2][4];
#pragma unroll
            for (int kt2 = 0; kt2 < 2; ++kt2)
#pragma unroll
                for (int qt = 0; qt < 4; ++qt) { f32x4 a = (f32x4){0.f, 0.f, 0.f, 0.f}; a = mfma16(ak[kt2][0], bq[qt][0], a); a = mfma16(ak[kt2][1], bq[qt][1], a); sacc[kt2][qt] = a; }
            if (loc) {
                const int jj = s >> 1, drow = r0 + jj - r + 7, kcb = (32 * s) & 63;
#pragma unroll
                for (int qt = 0; qt < 4; ++qt) {
                    const int qc = 16 * qt + fr, cs = min(max(qc - 8, 0), 48);
#pragma unroll
                    for (int kt2 = 0; kt2 < 2; ++kt2)
#pragma unroll
                        for (int j = 0; j < 4; ++j) { const int kc = kcb + 16 * kt2 + 4 * fq + j; const bool in = (kc >= cs) && (kc < cs + 16);
                            const int dcol = min(max(kc - qc + 15, 0), 30);
                            const float bias = btab[drow * 31 + dcol];
                            sacc[kt2][qt][j] = in ? (sacc[kt2][qt][j] * SC2 + bias) : -1e30f; }
                }
            } else {
#pragma unroll
                for (int qt = 0; qt < 4; ++qt)
#pragma unroll
                    for (int kt2 = 0; kt2 < 2; ++kt2) sacc[kt2][qt] = sacc[kt2][qt] * SC2;
            }
            bf16x8 bp[4];
#pragma unroll
            for (int qt = 0; qt < 4; ++qt) {
                float tm = fmaxf(fmaxf(fmaxf(sacc[0][qt][0], sacc[0][qt][1]), fmaxf(sacc[0][qt][2], sacc[0][qt][3])), fmaxf(fmaxf(sacc[1][qt][0], sacc[1][qt][1]), fmaxf(sacc[1][qt][2], sacc[1][qt][3])));
                tm = fmaxf(tm, __shfl_xor(tm, 16)); tm = fmaxf(tm, __shfl_xor(tm, 32));
                const float mnew = fmaxf(mrun[qt], tm), alpha = __builtin_amdgcn_exp2f(mrun[qt] - mnew);
                mrun[qt] = mnew;
                float pv[8], ps = 0.f;
#pragma unroll
                for (int kt2 = 0; kt2 < 2; ++kt2)
#pragma unroll
                    for (int j = 0; j < 4; ++j) { pv[kt2 * 4 + j] = __builtin_amdgcn_exp2f(sacc[kt2][qt][j] - mnew); ps += pv[kt2 * 4 + j]; }
                lsum[qt] = lsum[qt] * alpha + ps;
#pragma unroll
                for (int dt = 0; dt < 4; ++dt) oacc[dt][qt] = oacc[dt][qt] * alpha;
                u32x4 t4; t4.x = cvt_pk_bf16(pv[0], pv[1]); t4.y = cvt_pk_bf16(pv[2], pv[3]); t4.z = cvt_pk_bf16(pv[4], pv[5]); t4.w = cvt_pk_bf16(pv[6], pv[7]);
                bp[qt] = __builtin_bit_cast(bf16x8, t4);
            }
#pragma unroll
            for (int dt = 0; dt < 4; ++dt)
#pragma unroll
                for (int qt = 0; qt < 4; ++qt) oacc[dt][qt] = mfma16(av[dt], bp[qt], oacc[dt][qt]);
        }
#pragma unroll
        for (int qt = 0; qt < 4; ++qt) {
            float l = lsum[qt]; l += __shfl_xor(l, 16); l += __shfl_xor(l, 32);
            const float inv = 1.0f / l;
#pragma unroll
            for (int dt = 0; dt < 4; ++dt) { const f32x4 v = oacc[dt][qt] * inv; u32x2 w; w.x = cvt_pk_bf16(v[0], v[1]); w.y = cvt_pk_bf16(v[2], v[3]);
                *(u32x2*)(O + (size_t)(tq0 + 16 * qt + fr) * 1024 + h * 64 + 16 * dt + 4 * fq) = w; }
        }
    }
}

__device__ __forceinline__ void lru_gates_phase(const bf16_t* UC, const bf16_t* WG, const float* bgates, const float* lam, bf16_t* LAB, LAS unsigned char* lds, int c, int G, int tid) {
    const int wid = tid >> 6, lane = tid & 63, fr = lane & 15, fq = lane >> 4;
    LAS float* tab_sp = (LAS float*)(lds + 79872);
    LAS float* tab_b = (LAS float*)(lds + 79872 + 768);
    for (int u = c; u < 256; u += G) {
        const int nb = u & 15, chunk = u >> 4;
        for (int i = tid; i < 4608; i += 512) { const int row = i / 12, pc = i - row * 12; const u32x4 v = *(const u32x4*)(WG + ((size_t)nb * 384 + row) * 96 + pc * 8); *(LAS u32x4*)(lds + row * 208 + pc * 16) = v; }
        if (tid < 192) { const int d = tid / 96, jl = tid - d * 96; float v = 0.f; if (jl < 88) { const float lm = lam[d * DRNN + nb * 88 + jl]; v = 8.0f * log1pf(__expf(-lm)); } tab_sp[tid] = v; }
        else if (tid < 576) { const int t2 = tid - 192, q = t2 / 96, jl = t2 - q * 96; tab_b[t2] = (jl < 88) ? bgates[q * DRNN + nb * 88 + jl] : 0.f; }
        __syncthreads();
        for (int it = 0; it < 9; ++it) {
            const int row0 = chunk * 1152 + (it * 8 + wid) * 16;
            bf16x8 bu[3];
#pragma unroll
            for (int ks = 0; ks < 3; ++ks) bu[ks] = *(const bf16x8*)(UC + (size_t)(row0 + fr) * DRNN + nb * 88 + ks * 32 + fq * 8);
            f32x4 acc[4][6];
#pragma unroll
            for (int q = 0; q < 4; ++q)
#pragma unroll
                for (int jt = 0; jt < 6; ++jt) { f32x4 a = (f32x4){0.f, 0.f, 0.f, 0.f};
#pragma unroll
                    for (int ks = 0; ks < 3; ++ks) { const bf16x8 aw = *(const LAS bf16x8*)(lds + (q * 96 + 16 * jt + fr) * 208 + (ks * 32 + fq * 8) * 2); a = mfma16(aw, bu[ks], a); }
                    acc[q][jt] = a; }
#pragma unroll
            for (int jt = 0; jt < 6; ++jt) {
                if (jt < 5 || fq < 2) {
                    const int cl = 16 * jt + 4 * fq; const size_t off = (size_t)(row0 + fr) * DRNN + nb * 88 + cl;
                    const u32x2 ur = *(const u32x2*)(UC + off);
                    float uu[4]; uu[0] = bflo(ur.x); uu[1] = bfhi(ur.x); uu[2] = bflo(ur.y); uu[3] = bfhi(ur.y);
#pragma unroll
                    for (int d = 0; d < 2; ++d) {
                        float la[4], bb[4];
#pragma unroll
                        for (int j = 0; j < 4; ++j) {
                            const float gr = acc[2 * d][jt][j] + tab_b[(2 * d) * 96 + cl + j], gi = acc[2 * d + 1][jt][j] + tab_b[(2 * d + 1) * 96 + cl + j];
                            const float rr = pg8::fast_sigmoid(gr), ii = pg8::fast_sigmoid(gi);
                            const float l = -rr * tab_sp[d * 96 + cl + j];
                            const float a2 = __expf(2.0f * l);
                            la[j] = l; bb[j] = sqrtf(fmaxf(1.0f - a2, 0.f)) * ii * uu[j];
                        }
                        u32x2 w0, w1; w0.x = cvt_pk_bf16(la[0], la[1]); w0.y = cvt_pk_bf16(la[2], la[3]); w1.x = cvt_pk_bf16(bb[0], bb[1]); w1.y = cvt_pk_bf16(bb[2], bb[3]);
                        *(u32x2*)(LAB + (size_t)(2 * d) * MT * DRNN + off) = w0;
                        *(u32x2*)(LAB + (size_t)(2 * d + 1) * MT * DRNN + off) = w1;
                    }
                }
            }
        }
        __syncthreads();
    }
}

__device__ __forceinline__ void scan_seg(const bf16_t* LA, const bf16_t* BB, const bf16_t* GATE, bf16_t* YF, bf16_t* YIN, int rowbase, int n, int ch, bool rev, float& h) {
    for (int t0 = 0; t0 < n; t0 += 8) {
        float la[8], bb[8], gg[8], yf[8];
#pragma unroll
        for (int i = 0; i < 8; ++i) { const int t = rev ? (n - 1 - t0 - i) : (t0 + i); const size_t o = (size_t)(rowbase + t) * DRNN + ch;
            la[i] = bf2f(LA[o]); bb[i] = bf2f(BB[o]); if (rev) { gg[i] = bf2f(GATE[o]); yf[i] = bf2f(YF[o]); } }
#pragma unroll
        for (int i = 0; i < 8; ++i) { const int t = rev ? (n - 1 - t0 - i) : (t0 + i); const size_t o = (size_t)(rowbase + t) * DRNN + ch;
            h = __expf(la[i]) * h + bb[i];
            if (rev) YIN[o] = f2bf(gg[i] * (yf[i] + h)); else YF[o] = f2bf(h); }
    }
}

enum { OP_FFN_IN = 0, OP_FFN_OUT, OP_LN_FFN, OP_LN_MIX, OP_QK, OP_VT, OP_ATT, OP_NA_O, OP_LIN, OP_CONV4, OP_GATES, OP_SCAN, OP_LOUT, OP_SIN, OP_CONV3, OP_SOUT };
struct Op { int op, l, s, sync; };
__constant__ Op PROG[] = {
    {OP_FFN_IN, 0, 0, 1}, {OP_FFN_OUT, 0, 0, 1}, {OP_LN_FFN, 0, 0, 1},
    {OP_QK, 0, 0, 0}, {OP_VT, 0, 0, 1}, {OP_ATT, 0, 0, 1}, {OP_NA_O, 0, 0, 1}, {OP_LN_MIX, 0, 0, 1},
    {OP_FFN_IN, 0, 1, 1}, {OP_FFN_OUT, 0, 1, 1}, {OP_LN_FFN, 0, 1, 1},
    {OP_FFN_IN, 1, 0, 1}, {OP_FFN_OUT, 1, 0, 1}, {OP_LN_FFN, 1, 0, 1},
    {OP_LIN, 1, 0, 1}, {OP_CONV4, 1, 0, 1}, {OP_GATES, 1, 0, 1}, {OP_SCAN, 1, 0, 1}, {OP_LOUT, 1, 0, 1}, {OP_LN_MIX, 1, 0, 1},
    {OP_FFN_IN, 1, 1, 1}, {OP_FFN_OUT, 1, 1, 1}, {OP_LN_FFN, 1, 1, 1},
    {OP_FFN_IN, 2, 0, 1}, {OP_FFN_OUT, 2, 0, 1}, {OP_LN_FFN, 2, 0, 1},
    {OP_SIN, 2, 0, 1}, {OP_CONV3, 2, 0, 1}, {OP_SOUT, 2, 0, 1}, {OP_LN_MIX, 2, 0, 1},
    {OP_FFN_IN, 2, 1, 1}, {OP_FFN_OUT, 2, 1, 1}, {OP_LN_FFN, 2, 1, 1},
    {OP_FFN_IN, 3, 0, 1}, {OP_FFN_OUT, 3, 0, 1}, {OP_LN_FFN, 3, 0, 1},
    {OP_QK, 3, 0, 0}, {OP_VT, 3, 0, 1}, {OP_ATT, 3, 0, 1}, {OP_NA_O, 3, 0, 1}, {OP_LN_MIX, 3, 0, 1},
    {OP_FFN_IN, 3, 1, 1}, {OP_FFN_OUT, 3, 1, 1}, {OP_LN_FFN, 3, 1, 0},
};
constexpr int NPROG = sizeof(PROG) / sizeof(Op);

__global__ void __launch_bounds__(512, 2) fwd_kernel(Params p) {
    extern __shared__ __attribute__((aligned(16))) unsigned char smem[];
    cg::grid_group grid = cg::this_grid();
    LAS unsigned char* lds = (LAS unsigned char*)smem;
    const int G = gridDim.x, c = blockIdx.x;
    unsigned char* ws = p.ws;
    {
        const int tid = threadIdx.x;
        const int gtid = c * 512 + tid, ngt = G * 512;
        bf16_t* W_G = (bf16_t*)(ws + OFF_W_G); float* MOD = (float*)(ws + OFF_MOD);
        LAS float* fl = (LAS float*)lds;
        constexpr int NT = 8 * 704 + 8 * 352 + 2 * 256 + 2 * 128 + 2 * 128 + 352 + 176 + 384 + 128;
        for (int u = c; u < NT; u += G) {
            int r = u; const float* src; size_t doff; int ld, col0 = 0, K = 1024, N, base = 1 << 30, Hh = 0;
            if (r < 8 * 704) { const int j = r / 704; r -= j * 704; src = p.ffn_w_in + (size_t)j * 1024 * 5632; doff = OFF_W_FFN_IN + (size_t)j * SZ_FFN_IN; ld = 5632; N = 5632; base = 0; Hh = 2816; }
            else if ((r -= 8 * 704) < 8 * 352) { const int j = r / 352; r -= j * 352; src = p.ffn_w_out + (size_t)j * 2816 * 1024; doff = OFF_W_FFN_OUT + (size_t)j * SZ_FFN_OUT; ld = 1024; N = 1024; K = 2816; }
            else if ((r -= 8 * 352) < 2 * 256) { const int j = r / 256; r -= j * 256; src = p.na_w_qkv + (size_t)j * 1024 * 3072; doff = OFF_W_QK + (size_t)j * 2048 * 1024 * 2; ld = 3072; N = 2048; }
            else if ((r -= 2 * 256) < 2 * 128) { const int j = r / 128; r -= j * 128; src = p.na_w_qkv + (size_t)j * 1024 * 3072; doff = OFF_W_V + (size_t)j * 1024 * 1024 * 2; ld = 3072; N = 1024; col0 = 2048; }
            else if ((r -= 2 * 128) < 2 * 128) { const int j = r / 128; r -= j * 128; src = p.na_w_o + (size_t)j * 1024 * 1024; doff = OFF_W_O + (size_t)j * 1024 * 1024 * 2; ld = 1024; N = 1024; }
            else if ((r -= 2 * 128) < 352) { src = p.lru_w_in; doff = OFF_W_LIN; ld = 2816; N = 2816; }
            else if ((r -= 352) < 176) { src = p.lru_w_out; doff = OFF_W_LOUT; ld = 1024; N = 1024; K = 1408; }
            else if ((r -= 176) < 384) { src = p.sc_w_in; doff = OFF_W_SIN; ld = 3072; N = 3072; base = 1024; Hh = 1024; }
            else { r -= 384; src = p.sc_w_out; doff = OFF_W_SOUT; ld = 1024; N = 1024; }
            conv_tile(src, ld, col0, K, N, base, Hh, (bf16_t*)(ws + doff), r, fl, tid);
        }
        for (int i = gtid; i < 16 * 384 * 96; i += ngt) {
            const int k = i % 96, rj = (i / 96) % 384, nb = i / (96 * 384), q = rj / 96, j = rj - q * 96;
            float v = 0.f; if (j < 88 && k < 88) v = p.lru_wg[(((size_t)q * 16 + nb) * 88 + k) * 88 + j];
            W_G[i] = f2bf(v);
        }
        LAS float* scnd = (LAS float*)lds;
        LAS float* red = (LAS float*)(lds + 36864);
        __syncthreads();
        for (int i = tid; i < 9216; i += 512) { const float v = (i < 8192) ? p.c[i] : p.c_ctx[i - 8192]; scnd[i] = pg8::silu_f(v); }
        __syncthreads();
        for (int u = c; u < 576; u += G) {
            const int l = u / 144, n0 = (u - l * 144) * 64, col = tid & 63, kg = tid >> 6;
            const float* w = p.mod_w + (size_t)l * 1024 * MODLD + n0 + col;
            float a9[9];
#pragma unroll
            for (int i = 0; i < 9; ++i) a9[i] = 0.f;
#pragma unroll 8
            for (int k = kg * 128; k < kg * 128 + 128; ++k) { const float wv = w[(size_t)k * MODLD];
#pragma unroll
                for (int i = 0; i < 9; ++i) a9[i] += scnd[i * 1024 + k] * wv; }
#pragma unroll
            for (int i = 0; i < 9; ++i) red[(kg * 9 + i) * 64 + col] = a9[i];
            __syncthreads();
            for (int idx = tid; idx < 576; idx += 512) { const int i = idx >> 6, cc = idx & 63; float s = p.mod_b[l * MODLD + n0 + cc];
#pragma unroll
                for (int k2 = 0; k2 < 8; ++k2) s += red[(k2 * 9 + i) * 64 + cc];
                MOD[((size_t)l * 9 + i) * MODLD + n0 + cc] = s; }
            __syncthreads();
        }
    }
    grid.sync();
    {
        const int tid = threadIdx.x, wid = tid >> 6, lane = tid & 63;
        float* MOD = (float*)(ws + OFF_MOD); float* XZ = (float*)(ws + OFF_XZ); bf16_t* H = (bf16_t*)(ws + OFF_H);
        for (int row = c * 8 + wid; row < MT; row += G * 8) {
            const float* srow = row < ML ? p.x + (size_t)row * 1024 : p.ctx + (size_t)(row - ML) * 1024;
            const int mi = row < ML ? (row >> 11) : 8;
#pragma unroll
            for (int j = 0; j < 4; ++j) { const int col = 256 * j + 4 * lane; const f32x4 v = *(const f32x4*)(srow + col);
                *(f32x4*)(XZ + (size_t)row * 1024 + col) = v;
                const f32x4 sh = *(const f32x4*)(MOD + (size_t)mi * MODLD + col), sc = *(const f32x4*)(MOD + (size_t)mi * MODLD + 1024 + col);
                const f32x4 hv = v * (sc + 1.0f) + sh; u32x2 w; w.x = cvt_pk_bf16(hv[0], hv[1]); w.y = cvt_pk_bf16(hv[2], hv[3]);
                *(u32x2*)(H + (size_t)row * 1024 + col) = w; }
        }
    }
    grid.sync();

    for (int pc = 0; pc < NPROG; ++pc) {
        const int op = PROG[pc].op, l = PROG[pc].l, s = PROG[pc].s, dosync = PROG[pc].sync;
        int tidv = threadIdx.x; asm volatile("" : "+v"(tidv));
        const int tid = tidv, wid = tid >> 6, lane = tid & 63;
        const int gw = c * 8 + wid, ngw = G * 8, gtid = c * 512 + tid, ngt = G * 512;
        float* MOD = (float*)(ws + OFF_MOD); float* XZ = (float*)(ws + OFF_XZ);
        bf16_t* H = (bf16_t*)(ws + OFF_H); bf16_t* ACT = (bf16_t*)(ws + OFF_ACT); bf16_t* UCONV = (bf16_t*)(ws + OFF_UCONV); bf16_t* LAB = (bf16_t*)(ws + OFF_LAB);
        const float* MODL = MOD + (size_t)l * 9 * MODLD;
        const int Mff = (l == 3 && s == 1) ? ML : MT;
        const int Mmix = (l == 3) ? ML : MT;
        const int idx = l / 3;
        switch (op) {
        case OP_FFN_IN: case OP_SIN: {
            pg8::Gemm g; pg8::EpiPair E;
            if (op == OP_FFN_IN) { g = pg8::Gemm{H, (const bf16_t*)(ws + OFF_W_FFN_IN + (size_t)(l * 2 + s) * SZ_FFN_IN), Mff, 5632, 1024}; E = pg8::EpiPair{ACT, ACT, DFF, DFF, 0}; }
            else { g = pg8::Gemm{H, (const bf16_t*)(ws + OFF_W_SIN), MT, 3072, 1024}; E = pg8::EpiPair{ACT, ACT + (size_t)MT * 1024, 1024, 1024, 1}; }
            pg8::StaticOrder S; S.init(g.M, g.N, G, c);
            pg8::gemm_phase<pg8::EpiPair, pg8::StaticOrder, true, true>(lds, g, S, E);
        } break;
        case OP_QK: case OP_VT: case OP_LIN: {
            pg8::Gemm g; pg8::EpiSplit E; int cc = c;
            if (op == OP_QK) { g = pg8::Gemm{H, (const bf16_t*)(ws + OFF_W_QK + (size_t)idx * 2048 * 1024 * 2), MT, 2048, 1024}; E = pg8::EpiSplit{ACT, ACT, 1 << 30, 2048, 2048, 0}; }
            else if (op == OP_VT) { bf16_t* VT = ACT + (size_t)MT * 2048; g = pg8::Gemm{(const bf16_t*)(ws + OFF_W_V + (size_t)idx * 1024 * 1024 * 2), H, 1024, MT, 1024}; E = pg8::EpiSplit{VT, VT, 1 << 30, MT, MT, 0}; cc = (c + 192) % G; }
            else { g = pg8::Gemm{H, (const bf16_t*)(ws + OFF_W_LIN), MT, 2816, 1024}; E = pg8::EpiSplit{ACT, ACT + (size_t)MT * DRNN, DRNN, DRNN, DRNN, 1}; }
            pg8::StaticOrder S; S.init(g.M, g.N, G, cc);
            pg8::gemm_phase<pg8::EpiSplit, pg8::StaticOrder, true, true>(lds, g, S, E);
        } break;
        case OP_FFN_OUT: case OP_NA_O: case OP_LOUT: case OP_SOUT: {
            pg8::Gemm g; pg8::EpiRes E;
            if (op == OP_FFN_OUT) { g = pg8::Gemm{ACT, (const bf16_t*)(ws + OFF_W_FFN_OUT + (size_t)(l * 2 + s) * SZ_FFN_OUT), Mff, 1024, 2816}; E = pg8::EpiRes{XZ, MODL + (s == 0 ? 2 : 8) * 1024, 0.5f}; }
            else if (op == OP_NA_O) { g = pg8::Gemm{H, (const bf16_t*)(ws + OFF_W_O + (size_t)idx * 1024 * 1024 * 2), Mmix, 1024, 1024}; E = pg8::EpiRes{XZ, MODL + 5 * 1024, 1.0f}; }
            else if (op == OP_LOUT) { g = pg8::Gemm{UCONV, (const bf16_t*)(ws + OFF_W_LOUT), Mmix, 1024, DRNN}; E = pg8::EpiRes{XZ, MODL + 5 * 1024, 1.0f}; }
            else { g = pg8::Gemm{ACT + (size_t)2 * MT * 1024, (const bf16_t*)(ws + OFF_W_SOUT), Mmix, 1024, 1024}; E = pg8::EpiRes{XZ, MODL + 5 * 1024, 1.0f}; }
            pg8::StaticOrder S; S.init(g.M, g.N, G, c);
            pg8::gemm_phase<pg8::EpiRes, pg8::StaticOrder, true, true>(lds, g, S, E);
        } break;
        case OP_LN_FFN: {
            const bool fin = (l == 3 && s == 1);
            const int j3 = (s == 0) ? 0 : 2;
            const float* modn = fin ? MOD : ((s == 0) ? (MODL + 3 * 1024) : (MOD + (size_t)(l + 1) * 9 * MODLD));
            ln_phase(XZ, H, p.out, p.ln_g + (l * 3 + j3) * 1024, p.ln_b + (l * 3 + j3) * 1024, modn, fin, Mff, gw, ngw, lane);
        } break;
        case OP_LN_MIX: {
            ln_phase(XZ, H, p.out, p.ln_g + (l * 3 + 1) * 1024, p.ln_b + (l * 3 + 1) * 1024, MODL + 6 * 1024, false, Mmix, gw, ngw, lane);
        } break;
        case OP_ATT: {
            attn_phase(ACT, ACT + (size_t)MT * 2048, H, p.na_rpb + (size_t)idx * 16 * 465, l < 3, (LAS float*)lds + wid * 480, gw, ngw, lane);
        } break;
        case OP_CONV4: {
            const bf16_t* U = ACT + (size_t)MT * DRNN;
            for (int it = gtid; it < MT * 176; it += ngt) {
                const int row = it / 176, c0 = (it - row * 176) * 8;
                int sq, len; if (row < ML) { sq = row & 2047; len = SEQ; } else { sq = (row - ML) & 255; len = CTXL; }
                float a8[8];
                { const f32x4 b0 = *(const f32x4*)(p.lru_conv_b + c0), b1 = *(const f32x4*)(p.lru_conv_b + c0 + 4);
                  a8[0] = b0[0]; a8[1] = b0[1]; a8[2] = b0[2]; a8[3] = b0[3]; a8[4] = b1[0]; a8[5] = b1[1]; a8[6] = b1[2]; a8[7] = b1[3]; }
#pragma unroll
                for (int k = 0; k < 4; ++k) { const int t = sq + k - 2;
                    if (t >= 0 && t < len) { const u32x4 uv = *(const u32x4*)(U + (size_t)(row + k - 2) * DRNN + c0);
                        const f32x4 w0 = *(const f32x4*)(p.lru_conv_w + k * DRNN + c0), w1 = *(const f32x4*)(p.lru_conv_w + k * DRNN + c0 + 4);
                        a8[0] += w0[0] * bflo(uv.x); a8[1] += w0[1] * bfhi(uv.x); a8[2] += w0[2] * bflo(uv.y); a8[3] += w0[3] * bfhi(uv.y);
                        a8[4] += w1[0] * bflo(uv.z); a8[5] += w1[1] * bfhi(uv.z); a8[6] += w1[2] * bflo(uv.w); a8[7] += w1[3] * bfhi(uv.w); } }
                u32x4 o; o.x = cvt_pk_bf16(a8[0], a8[1]); o.y = cvt_pk_bf16(a8[2], a8[3]); o.z = cvt_pk_bf16(a8[4], a8[5]); o.w = cvt_pk_bf16(a8[6], a8[7]);
                *(u32x4*)(UCONV + (size_t)row * DRNN + c0) = o;
            }
        } break;
        case OP_GATES: {
            lru_gates_phase(UCONV, (const bf16_t*)(ws + OFF_W_G), p.lru_bg, p.lru_lam, LAB, lds, c, G, tid);
        } break;
        case OP_SCAN: {
            if (wid == 0) {
                bf16_t* GATE = ACT; bf16_t* U = ACT + (size_t)MT * DRNN;
                for (int wv = c; wv < 176; wv += G) {
                    const int ix = wv * 64 + lane, b = ix / DRNN, ch = ix - b * DRNN;
                    const size_t PL = (size_t)MT * DRNN;
                    float h = 0.f;
                    scan_seg(LAB, LAB + PL, GATE, U, UCONV, ML + b * CTXL, CTXL, ch, false, h);
                    scan_seg(LAB, LAB + PL, GATE, U, UCONV, b * SEQ, SEQ, ch, false, h);
                    h = 0.f;
                    scan_seg(LAB + 2 * PL, LAB + 3 * PL, GATE, U, UCONV, ML + b * CTXL, CTXL, ch, true, h);
                    scan_seg(LAB + 2 * PL, LAB + 3 * PL, GATE, U, UCONV, b * SEQ, SEQ, ch, true, h);
                }
            }
        } break;
        case OP_CONV3: {
            const bf16_t* BG = ACT; const bf16_t* PP = ACT + (size_t)MT * 1024; bf16_t* YIN = ACT + (size_t)2 * MT * 1024;
            for (int it = gtid; it < MT * 128; it += ngt) {
                const int row = it >> 7, c0 = (it & 127) * 8;
                int sq, len; if (row < ML) { sq = row & 2047; len = SEQ; } else { sq = (row - ML) & 255; len = CTXL; }
                float a8[8];
#pragma unroll
                for (int i = 0; i < 8; ++i) a8[i] = 0.f;
#pragma unroll
                for (int k = 0; k < 3; ++k) { const int t = sq + k - 1;
                    if (t >= 0 && t < len) { const u32x4 uv = *(const u32x4*)(PP + (size_t)(row + k - 1) * 1024 + c0);
                        const f32x4 w0 = *(const f32x4*)(p.sc_conv_w + k * 1024 + c0), w1 = *(const f32x4*)(p.sc_conv_w + k * 1024 + c0 + 4);
                        a8[0] += w0[0] * bflo(uv.x); a8[1] += w0[1] * bfhi(uv.x); a8[2] += w0[2] * bflo(uv.y); a8[3] += w0[3] * bfhi(uv.y);
                        a8[4] += w1[0] * bflo(uv.z); a8[5] += w1[1] * bfhi(uv.z); a8[6] += w1[2] * bflo(uv.w); a8[7] += w1[3] * bfhi(uv.w); } }
                const u32x4 bv = *(const u32x4*)(BG + (size_t)row * 1024 + c0);
                u32x4 o; o.x = cvt_pk_bf16(a8[0] * bflo(bv.x), a8[1] * bfhi(bv.x)); o.y = cvt_pk_bf16(a8[2] * bflo(bv.y), a8[3] * bfhi(bv.y));
                o.z = cvt_pk_bf16(a8[4] * bflo(bv.z), a8[5] * bfhi(bv.z)); o.w = cvt_pk_bf16(a8[6] * bflo(bv.w), a8[7] * bfhi(bv.w));
                *(u32x4*)(YIN + (size_t)row * 1024 + c0) = o;
            }
        } break;
        default: break;
        }
        if (dosync) grid.sync();
    }
}

extern "C" void kernel_launch(void* const* d_in, const int* in_sizes, int n_in, void* d_out, int out_size, void* d_ws, size_t ws_size, hipStream_t stream) {
    static int grid_blocks = 0;
    if (grid_blocks == 0) {
        if (n_in != 23 || ws_size < WS_END) { fprintf(stderr, "kernel_launch: need 23 inputs and %zu bytes of workspace (got %d, %zu)\n", (size_t)WS_END, n_in, ws_size); grid_blocks = -1; return; }
        int dev = 0, cus = 0, per_cu = 0;
        (void)hipGetDevice(&dev);
        (void)hipDeviceGetAttribute(&cus, hipDeviceAttributeMultiprocessorCount, dev);
        if (hipFuncSetAttribute((const void*)fwd_kernel, hipFuncAttributeMaxDynamicSharedMemorySize, LDS_BYTES) != hipSuccess) { fprintf(stderr, "kernel_launch: hipFuncSetAttribute failed\n"); grid_blocks = -1; return; }
        (void)hipOccupancyMaxActiveBlocksPerMultiprocessor(&per_cu, (const void*)fwd_kernel, 512, LDS_BYTES);
        if (per_cu < 1) { fprintf(stderr, "kernel_launch: occupancy query returned %d\n", per_cu); per_cu = 1; }
        (void)hipGetLastError();
        grid_blocks = cus * per_cu;
    }
    if (grid_blocks < 0) return;
    Params p{};
    const float** pp = (const float**)&p;
    for (int i = 0; i < 23; ++i) pp[i] = (const float*)d_in[i];
    p.out = (float*)d_out; p.ws = (unsigned char*)d_ws;
    void* args[] = {&p};
    hipError_t e = hipLaunchCooperativeKernel((const void*)fwd_kernel, dim3(grid_blocks), dim3(512), args, LDS_BYTES, stream);
    if (e != hipSuccess) fprintf(stderr, "cooperative launch failed: %s (grid %d)\n", hipGetErrorString(e), grid_blocks);
}
```

```cpp
#include <hip/hip_runtime.h>
#include <hip/hip_cooperative_groups.h>
#include <cstdio>
#include <cstdint>
namespace cg = cooperative_groups;
namespace pg8 {
#define PG8_LAS __attribute__((address_space(3)))
typedef unsigned short bf16_t;
typedef short bf16x8 __attribute__((ext_vector_type(8)));
typedef float f32x4 __attribute__((ext_vector_type(4)));
typedef unsigned u32x4 __attribute__((ext_vector_type(4)));
constexpr int BM = 256, BK = 64, HALF = 128, HTB = HALF * BK * 2  , STAGE_BYTES = 8 * HTB, NXCD = 8, WGM = 8;

__host__ __device__ __forceinline__ int lds_byte(int r, int c) { const int st = (r >> 4) * 2 + (c >> 5), rr = r & 15, cc = c & 31, ob = rr * 64 + cc * 2; return st * 1024 + (ob ^ (((ob >> 9) & 1) << 5)); }
__host__ __device__ __forceinline__ void stage_rc(int b, int& R, int& C) { const int st = b / 1024, sb = b % 1024, swz = sb ^ (((sb >> 9) & 1) << 5); R = (st >> 1) * 16 + swz / 64; C = (st & 1) * 32 + (swz % 64) / 2; }
__host__ __device__ __forceinline__ int perm32(int rho) { const int n = rho >> 4, i = rho & 15; return 8 * (i >> 2) + 4 * n + (i & 3); }

struct Unit { int pm, pn; };
struct Gemm { const bf16_t* A; const bf16_t* Bt; int M, N, K; };

struct StaticOrder {
    int nM, nN, nwg, G, c;
    __host__ __device__ void init(int M, int N, int G_, int c_) { nM = M / BM; nN = N / BM; nwg = nM * nN; G = G_; c = c_; }
    __host__ __device__ bool next(int i, Unit& u) const {
        const long L = (long)i * G + c; if (L >= nwg) return false;
        int wgid = (int)L; { const int q = nwg / NXCD, r = nwg % NXCD, xcd = wgid % NXCD, off = wgid / NXCD; wgid = (xcd < r ? xcd * (q + 1) : r * (q + 1) + (xcd - r) * q) + off; }
        const int nig = WGM * nN, gid = wgid / nig, fm = gid * WGM, gsz = (nM - fm) < WGM ? (nM - fm) : WGM;
        u.pm = fm + ((wgid % nig) % gsz); u.pn = (wgid % nig) / gsz; return true;
    }
    __device__ __forceinline__ void a_ready(const Unit&) const {}
    __device__ __forceinline__ void done(const Unit&) const {}
};

__device__ __forceinline__ unsigned cvt_pk_bf16(float lo, float hi) { unsigned r; asm volatile("v_cvt_pk_bf16_f32 %0, %1, %2" : "=v"(r) : "v"(lo), "v"(hi)); return r; }
typedef float f32x2 __attribute__((ext_vector_type(2)));
typedef unsigned u32x2 __attribute__((ext_vector_type(2)));
__device__ __forceinline__ float fast_sigmoid(float v) { return __builtin_amdgcn_rcpf(1.0f + __expf(-v)); }
__device__ __forceinline__ float silu_f(float v) { return v * fast_sigmoid(v); }
__device__ __forceinline__ float gelu_tanh_f(float v) { const float y = 0.7978845608028654f * (v + 0.044715f * v * v * v); return v * fast_sigmoid(2.0f * y); }

struct EpiPair {
    static constexpr bool PERM = true, AFTER_DRAIN = false;
    bf16_t* O0; bf16_t* O1; int ld0, ld1; int mode;
    __device__ __forceinline__ void operator()(const f32x4 (&acc)[2][2][4][2], const Unit& u, int wr, int wc, int fr, int fq) const {
        if (mode == 0) body<0>(acc, u, wr, wc, fr, fq); else body<1>(acc, u, wr, wc, fr, fq);
    }
    template <int MODE> __device__ __forceinline__ void body(const f32x4 (&acc)[2][2][4][2], const Unit& u, int wr, int wc, int fr, int fq) const {
        const int row0 = u.pm * BM + wr * 64 + fr;
        if (MODE == 1 && u.pn < 4) {
            const int col0 = u.pn * BM + wc * 32 + 8 * fq;
#pragma unroll
            for (int ai = 0; ai < 2; ++ai)
#pragma unroll
                for (int m = 0; m < 4; ++m) { bf16_t* rowp = O0 + (size_t)(row0 + ai * HALF + m * 16) * ld0 + col0;
#pragma unroll
                    for (int bj = 0; bj < 2; ++bj) { const f32x4 v0 = acc[ai][bj][m][0], v1 = acc[ai][bj][m][1];
                        u32x4 w; w.x = cvt_pk_bf16(v0[0], v0[1]); w.y = cvt_pk_bf16(v0[2], v0[3]); w.z = cvt_pk_bf16(v1[0], v1[1]); w.w = cvt_pk_bf16(v1[2], v1[3]);
                        *(u32x4*)(rowp + bj * HALF) = w; } }
        } else {
            const int pnn = (MODE == 1) ? (u.pn - 4) : u.pn;
            bf16_t* O = (MODE == 1) ? O1 : O0; const int ld = (MODE == 1) ? ld1 : ld0;
            const int col0 = pnn * HALF + wc * 32 + 8 * fq;
#pragma unroll
            for (int ai = 0; ai < 2; ++ai)
#pragma unroll
                for (int m = 0; m < 4; ++m) {
                    float r[8];
#pragma unroll
                    for (int n = 0; n < 2; ++n)
#pragma unroll
                        for (int j = 0; j < 4; ++j) { const float g = acc[ai][0][m][n][j], uu = acc[ai][1][m][n][j]; r[n * 4 + j] = (MODE == 0) ? silu_f(g) * uu : g * uu; }
                    u32x4 w; w.x = cvt_pk_bf16(r[0], r[1]); w.y = cvt_pk_bf16(r[2], r[3]); w.z = cvt_pk_bf16(r[4], r[5]); w.w = cvt_pk_bf16(r[6], r[7]);
                    *(u32x4*)(O + (size_t)(row0 + ai * HALF + m * 16) * ld + col0) = w; }
        }
    }
};
struct EpiSplit {
    static constexpr bool PERM = true, AFTER_DRAIN = false;
    bf16_t* O0; bf16_t* O1; int split, ld0, ld1; int act;
    __device__ __forceinline__ void operator()(const f32x4 (&acc)[2][2][4][2], const Unit& u, int wr, int wc, int fr, int fq) const {
        if (act == 0) body<0>(acc, u, wr, wc, fr, fq); else body<1>(acc, u, wr, wc, fr, fq);
    }
    template <int ACT> __device__ __forceinline__ void body(const f32x4 (&acc)[2][2][4][2], const Unit& u, int wr, int wc, int fr, int fq) const {
        const int row0 = u.pm * BM + wr * 64 + fr;
#pragma unroll
        for (int bj = 0; bj < 2; ++bj) {
            const int cb = u.pn * BM + bj * HALF; const bool second = cb >= split;
            bf16_t* O = second ? O1 : O0; const int ld = second ? ld1 : ld0; const int col0 = (second ? cb - split : cb) + wc * 32 + 8 * fq;
#pragma unroll
            for (int ai = 0; ai < 2; ++ai)
#pragma unroll
                for (int m = 0; m < 4; ++m) { f32x4 v0 = acc[ai][bj][m][0], v1 = acc[ai][bj][m][1];
                    if (ACT == 1 && !second) {
#pragma unroll
                        for (int j = 0; j < 4; ++j) { v0[j] = gelu_tanh_f(v0[j]); v1[j] = gelu_tanh_f(v1[j]); } }
                    u32x4 w; w.x = cvt_pk_bf16(v0[0], v0[1]); w.y = cvt_pk_bf16(v0[2], v0[3]); w.z = cvt_pk_bf16(v1[0], v1[1]); w.w = cvt_pk_bf16(v1[2], v1[3]);
                    *(u32x4*)(O + (size_t)(row0 + ai * HALF + m * 16) * ld + col0) = w; }
        }
    }
};
struct EpiRes {
    static constexpr bool PERM = false, AFTER_DRAIN = false;
    float* XZ; const float* gate; float cmul;
    __device__ __forceinline__ void operator()(const f32x4 (&acc)[2][2][4][2], const Unit& u, int wr, int wc, int fr, int fq) const {
        const int mi = (u.pm < 64) ? (u.pm >> 3) : 8;
        const int row0 = u.pm * BM + wr * 64 + fr, col0 = u.pn * BM + wc * 32 + 4 * fq;
        const float* gp = gate + (size_t)mi * 9216 + col0;
        f32x4 gv[2][2];
#pragma unroll
        for (int bj = 0; bj < 2; ++bj)
#pragma unroll
            for (int n = 0; n < 2; ++n) gv[bj][n] = *(const f32x4*)(gp + bj * HALF + n * 16) * cmul;
#pragma unroll
        for (int ai = 0; ai < 2; ++ai)
#pragma unroll
            for (int m = 0; m < 4; ++m) { float* rowp = XZ + (size_t)(row0 + ai * HALF + m * 16) * 1024 + col0;
#pragma unroll
                for (int bj = 0; bj < 2; ++bj)
#pragma unroll
                    for (int n = 0; n < 2; ++n) { const f32x4 xv = *(const f32x4*)(rowp + bj * HALF + n * 16);
                        *(f32x4*)(rowp + bj * HALF + n * 16) = xv * 1.6817928305074290f + gv[bj][n] * acc[ai][bj][m][n]; } }
    }
};
template <class Epi, class Sched, bool ALIGN_EPI = false, bool SP2 = false>
__device__ __forceinline__ void gemm_phase(PG8_LAS unsigned char* lds, const Gemm g, const Sched& S, const Epi& E) {
    int tidv = threadIdx.x; asm volatile("" : "+v"(tidv)); const int tid = tidv, wid = __builtin_amdgcn_readfirstlane(tid >> 6), lane = tid & 63, wr = wid >> 2, wc = wid & 3, fr = lane & 15, fq = lane >> 4;
    const int K = g.K, nt = K / BK;
    unsigned voffA[2], voffB[2];
#pragma unroll
    for (int i = 0; i < 2; ++i) { int R, C; stage_rc(tid * 16 + i * 8192, R, C); const int Rb = Epi::PERM ? ((R & ~31) + perm32(R & 31)) : R;
        voffA[i] = (unsigned)(R * K + C) * 2u; voffB[i] = (unsigned)(Rb * K + C) * 2u; }
    const size_t kstep = (size_t)(BK * 2);
    const size_t hstep = (size_t)HALF * K * 2;
    const size_t tstep = 2 * hstep;
    const unsigned ldsw = (unsigned)wid * 1024u;
    const int aoff = lds_byte(wr * 64 + fr, fq * 8), boff = lds_byte(wc * 32 + fr, fq * 8);
#define PG8_SA(b, h) (((b) * 2 + (h)) * HTB)
#define PG8_SB(b, h) ((4 + (b) * 2 + (h)) * HTB)
#define PG8_STAGE(bufoff, gbase, voff) do { _Pragma("unroll") for (int _i = 0; _i < 2; ++_i) \
        __builtin_amdgcn_global_load_lds((const unsigned*)((const char*)(gbase) + (voff)[_i]), (PG8_LAS unsigned*)(lds + (bufoff) + ldsw + _i * 8192), 16, 0, 0); } while (0)
#define PG8_LDA(dst, b, h) do { _Pragma("unroll") for (int m = 0; m < 4; ++m) _Pragma("unroll") for (int k = 0; k < 2; ++k) dst[m][k] = *(const PG8_LAS bf16x8*)(lds + PG8_SA(b, h) + aoff + m * 2048 + k * 1024); } while (0)
#define PG8_LDB(dst, b, h) do { _Pragma("unroll") for (int n = 0; n < 2; ++n) _Pragma("unroll") for (int k = 0; k < 2; ++k) dst[n][k] = *(const PG8_LAS bf16x8*)(lds + PG8_SB(b, h) + boff + n * 2048 + k * 1024); } while (0)
#define PG8_MMA(ai, bj, At, Bt) do { __builtin_amdgcn_s_setprio(1); _Pragma("unroll") for (int m = 0; m < 4; ++m) _Pragma("unroll") for (int n = 0; n < 2; ++n) _Pragma("unroll") for (int k = 0; k < 2; ++k) \
        acc[ai][bj][m][n] = __builtin_amdgcn_mfma_f32_16x16x32_bf16(Bt[n][k], At[m][k], acc[ai][bj][m][n], 0, 0, 0); __builtin_amdgcn_s_setprio(0); } while (0)
#define PG8_WAIT_V(n) asm volatile("s_waitcnt vmcnt(" #n ")" ::: "memory")
#define PG8_WAIT_L(n) asm volatile("s_waitcnt lgkmcnt(" #n ")" ::: "memory")
#define PG8_BAR __builtin_amdgcn_s_barrier()
#define PG8_SCHED __builtin_amdgcn_sched_barrier(0)
    Unit cur, nxt; int ui = 0;
    if (!S.next(0, cur)) return;
    f32x4 acc[2][2][4][2];
#pragma unroll
    for (int a = 0; a < 2; ++a)
#pragma unroll
        for (int b = 0; b < 2; ++b)
#pragma unroll
            for (int m = 0; m < 4; ++m)
#pragma unroll
                for (int n = 0; n < 2; ++n) acc[a][b][m][n] = (f32x4){0.f, 0.f, 0.f, 0.f};
    bf16x8 At[4][2], B0[2][2], B1[2][2];
    const char* cA = (const char*)g.A + (size_t)cur.pm * tstep; const char* cB = (const char*)g.Bt + (size_t)cur.pn * tstep;
    S.a_ready(cur);
    if constexpr (SP2) {
        PG8_STAGE(PG8_SB(0, 0), cB, voffB); PG8_STAGE(PG8_SB(0, 1), cB + hstep, voffB); PG8_STAGE(PG8_SA(0, 0), cA, voffA); PG8_STAGE(PG8_SA(0, 1), cA + hstep, voffA);
        if (wr == 1) PG8_BAR;
        PG8_WAIT_V(2); PG8_BAR;
        PG8_STAGE(PG8_SB(1, 0), cB + kstep, voffB); PG8_STAGE(PG8_SA(1, 0), cA + kstep, voffA); PG8_STAGE(PG8_SB(1, 1), cB + hstep + kstep, voffB);
        PG8_WAIT_V(6); PG8_BAR;
    } else {
        PG8_STAGE(PG8_SB(0, 0), cB, voffB); PG8_STAGE(PG8_SA(0, 0), cA, voffA); PG8_STAGE(PG8_SB(0, 1), cB + hstep, voffB); PG8_STAGE(PG8_SA(0, 1), cA + hstep, voffA);
        if (wr == 1) PG8_BAR;
        PG8_WAIT_V(4); PG8_BAR;
        PG8_STAGE(PG8_SB(1, 0), cB + kstep, voffB); PG8_STAGE(PG8_SA(1, 0), cA + kstep, voffA); PG8_STAGE(PG8_SB(1, 1), cB + hstep + kstep, voffB);
        PG8_WAIT_V(6); PG8_BAR;
    }
    for (;;) {
        const bool has_next = S.next(ui + 1, nxt);
        const char* nA = has_next ? (const char*)g.A + (size_t)nxt.pm * tstep : cA; const char* nB = has_next ? (const char*)g.Bt + (size_t)nxt.pn * tstep : cB;
        for (int t = 0; t < nt; t += 2) {
            const bool last = (t == nt - 2);
            const char* a1 = cA + (size_t)(t + 1) * kstep;
            const char* a2 = last ? nA : cA + (size_t)(t + 2) * kstep; const char* b2 = last ? nB : cB + (size_t)(t + 2) * kstep;
            const char* a3 = a2 + kstep; const char* b3 = b2 + kstep;
            if (last && has_next) S.a_ready(nxt);
            if constexpr (SP2) {
            PG8_LDB(B0, 0, 0); PG8_LDB(B1, 0, 1); PG8_SCHED; PG8_LDA(At, 0, 0); PG8_STAGE(PG8_SA(1, 1), a1 + hstep, voffA);
            PG8_WAIT_V(8); PG8_WAIT_L(0); PG8_BAR; PG8_MMA(0, 0, At, B0); PG8_MMA(0, 1, At, B1); PG8_BAR; PG8_SCHED;
            PG8_LDA(At, 0, 1); PG8_STAGE(PG8_SB(0, 0), b2, voffB); PG8_STAGE(PG8_SB(0, 1), b2 + hstep, voffB); PG8_STAGE(PG8_SA(0, 0), a2, voffA);
            PG8_WAIT_V(8); PG8_WAIT_L(0); PG8_BAR; PG8_MMA(1, 0, At, B0); PG8_MMA(1, 1, At, B1); PG8_BAR; PG8_SCHED;
            PG8_LDB(B0, 1, 0); PG8_LDB(B1, 1, 1); PG8_SCHED; PG8_LDA(At, 1, 0); PG8_STAGE(PG8_SA(0, 1), a2 + hstep, voffA);
            PG8_WAIT_V(8); PG8_WAIT_L(0); PG8_BAR; PG8_MMA(0, 0, At, B0); PG8_MMA(0, 1, At, B1); PG8_BAR; PG8_SCHED;
            PG8_LDA(At, 1, 1); PG8_STAGE(PG8_SB(1, 0), b3, voffB); PG8_STAGE(PG8_SB(1, 1), b3 + hstep, voffB); PG8_STAGE(PG8_SA(1, 0), a3, voffA);
            PG8_WAIT_V(8); PG8_WAIT_L(0); PG8_BAR; PG8_MMA(1, 0, At, B0); PG8_MMA(1, 1, At, B1); PG8_BAR; PG8_SCHED;
            } else {
            PG8_LDB(B0, 0, 0); PG8_SCHED; PG8_LDA(At, 0, 0); PG8_STAGE(PG8_SA(1, 1), a1 + hstep, voffA);
            PG8_WAIT_L(8); PG8_BAR; PG8_WAIT_L(0); PG8_MMA(0, 0, At, B0); PG8_BAR; PG8_SCHED;
            PG8_LDB(B1, 0, 1); PG8_STAGE(PG8_SB(0, 0), b2, voffB);
            PG8_BAR; PG8_WAIT_L(0); PG8_MMA(0, 1, At, B1); PG8_BAR;
            PG8_LDA(At, 0, 1); PG8_STAGE(PG8_SA(0, 0), a2, voffA);
            PG8_BAR; PG8_WAIT_L(0); PG8_MMA(1, 0, At, B0); PG8_BAR; PG8_SCHED;
            PG8_STAGE(PG8_SB(0, 1), b2 + hstep, voffB);
            PG8_WAIT_V(6); PG8_BAR; PG8_MMA(1, 1, At, B1); PG8_BAR;
            PG8_LDB(B0, 1, 0); PG8_SCHED; PG8_LDA(At, 1, 0); PG8_STAGE(PG8_SA(0, 1), a2 + hstep, voffA);
            PG8_WAIT_L(8); PG8_BAR; PG8_WAIT_L(0); PG8_MMA(0, 0, At, B0); PG8_BAR; PG8_SCHED;
            PG8_LDB(B1, 1, 1); PG8_STAGE(PG8_SB(1, 0), b3, voffB);
            PG8_BAR; PG8_WAIT_L(0); PG8_MMA(0, 1, At, B1); PG8_BAR;
            PG8_LDA(At, 1, 1); PG8_STAGE(PG8_SA(1, 0), a3, voffA);
            PG8_BAR; PG8_WAIT_L(0); PG8_MMA(1, 0, At, B0); PG8_BAR; PG8_SCHED;
            PG8_STAGE(PG8_SB(1, 1), b3 + hstep, voffB);
            PG8_WAIT_V(6); PG8_BAR; PG8_MMA(1, 1, At, B1); PG8_BAR;
            }
        }
        if constexpr (ALIGN_EPI) { if (wr == 0) PG8_BAR; }
        if constexpr (!Epi::AFTER_DRAIN) { E(acc, cur, wr, wc, fr, fq); S.done(cur); }
        if (!has_next) break;
#pragma unroll
        for (int a = 0; a < 2; ++a)
#pragma unroll
            for (int b = 0; b < 2; ++b)
#pragma unroll
                for (int m = 0; m < 4; ++m)
#pragma unroll
                    for (int n = 0; n < 2; ++n) acc[a][b][m][n] = (f32x4){0.f, 0.f, 0.f, 0.f};
        cur = nxt; cA = nA; cB = nB; ++ui;
        if constexpr (ALIGN_EPI) { if (wr == 1) PG8_BAR; }
    }
    PG8_WAIT_V(0);
    if constexpr (!ALIGN_EPI) { if (wr == 0) PG8_BAR; }
    PG8_BAR;
    if constexpr (Epi::AFTER_DRAIN) { E.fused(acc, cur, wr, wc, fr, fq, lds, wid, lane); S.done(cur); }
#undef PG8_SA
#undef PG8_SB
#undef PG8_STAGE
#undef PG8_LDA
#undef PG8_LDB
#undef PG8_MMA
#undef PG8_WAIT_V
#undef PG8_WAIT_L
#undef PG8_BAR
#undef PG8_SCHED
}
}

#define LAS __attribute__((address_space(3)))
using pg8::bf16_t; using pg8::bf16x8; using pg8::f32x4; using pg8::u32x4; using pg8::u32x2; using pg8::cvt_pk_bf16;

constexpr int NBATCH = 8, SEQ = 2048, CTXL = 256;
constexpr int ML = NBATCH * SEQ, MC = NBATCH * CTXL, MT = ML + MC;
constexpr int DFF = 2816, DRNN = 1408, MODLD = 9216;
constexpr int LDS_BYTES = 131072;
constexpr float LOG2E = 1.4426950408889634f;

struct Params {
    const float *x, *c, *ctx, *c_ctx, *mod_w, *mod_b, *ln_g, *ln_b, *ffn_w_in, *ffn_w_out, *na_w_qkv, *na_w_o, *na_rpb,
                *lru_w_in, *lru_conv_w, *lru_conv_b, *lru_wg, *lru_bg, *lru_lam, *lru_w_out, *sc_w_in, *sc_conv_w, *sc_w_out;
    float* out;
    unsigned char* ws;
};

constexpr size_t SZ_FFN_IN = (size_t)5632 * 1024 * 2, SZ_FFN_OUT = (size_t)1024 * 2816 * 2;
constexpr size_t OFF_W_FFN_IN = 0;
constexpr size_t OFF_W_FFN_OUT = OFF_W_FFN_IN + 8 * SZ_FFN_IN;
constexpr size_t OFF_W_QK = OFF_W_FFN_OUT + 8 * SZ_FFN_OUT;
constexpr size_t OFF_W_V = OFF_W_QK + 2 * (size_t)2048 * 1024 * 2;
constexpr size_t OFF_W_O = OFF_W_V + 2 * (size_t)1024 * 1024 * 2;
constexpr size_t OFF_W_LIN = OFF_W_O + 2 * (size_t)1024 * 1024 * 2;
constexpr size_t OFF_W_LOUT = OFF_W_LIN + (size_t)2816 * 1024 * 2;
constexpr size_t OFF_W_SIN = OFF_W_LOUT + (size_t)1024 * 1408 * 2;
constexpr size_t OFF_W_SOUT = OFF_W_SIN + (size_t)3072 * 1024 * 2;
constexpr size_t OFF_W_G = OFF_W_SOUT + (size_t)1024 * 1024 * 2;
constexpr size_t OFF_MOD = OFF_W_G + (size_t)16 * 384 * 96 * 2;
constexpr size_t OFF_XZ = OFF_MOD + (size_t)4 * 9 * 9216 * 4;
constexpr size_t OFF_H = OFF_XZ + (size_t)MT * 1024 * 4;
constexpr size_t OFF_ACT = OFF_H + (size_t)MT * 1024 * 2;
constexpr size_t OFF_UCONV = OFF_ACT + (size_t)MT * 3072 * 2;
constexpr size_t OFF_LAB = OFF_UCONV + (size_t)MT * 1408 * 2 + 256;
constexpr size_t WS_END = OFF_LAB + 4 * (size_t)MT * 1408 * 2 + 256;

__device__ __forceinline__ float bf2f(unsigned v) { return __uint_as_float(v << 16); }
__device__ __forceinline__ float bflo(unsigned v) { return __uint_as_float(v << 16); }
__device__ __forceinline__ float bfhi(unsigned v) { return __uint_as_float(v & 0xffff0000u); }
__device__ __forceinline__ bf16_t f2bf(float v) { return (bf16_t)(cvt_pk_bf16(v, 0.f) & 0xffffu); }
__device__ __forceinline__ float wave_sum(float v) {
#pragma unroll
    for (int o = 1; o < 64; o <<= 1) v += __shfl_xor(v, o);
    return v;
}
__device__ __forceinline__ f32x4 mfma16(bf16x8 a, bf16x8 b, f32x4 c) { return __builtin_amdgcn_mfma_f32_16x16x32_bf16(a, b, c, 0, 0, 0); }

__device__ __forceinline__ void conv_tile(const float* src, int ld, int col0, int K, int N, int base, int Hh, bf16_t* dst, int tile, LAS float* fl, int tid) {
    const int ntn = N >> 7, kb = tile / ntn, nb = tile - kb * ntn, k0 = kb * 64, n0 = nb * 128;
    int sc;
    if (n0 < base) sc = n0; else { const int q = n0 - base, pn = q >> 8, bj = (q >> 7) & 1; sc = base + bj * Hh + 128 * pn; }
    sc += col0;
    const int nn2 = (tid & 63) * 2;
#pragma unroll
    for (int i = 0; i < 8; ++i) { const int kk = (tid >> 6) + 8 * i; const float2 v = *(const float2*)(src + (size_t)(k0 + kk) * ld + sc + nn2); fl[kk * 129 + nn2] = v.x; fl[kk * 129 + nn2 + 1] = v.y; }
    __syncthreads();
    const int kk2 = 2 * (tid & 31);
#pragma unroll
    for (int i = 0; i < 8; ++i) { const int nn = (tid >> 5) + 16 * i; const unsigned w = cvt_pk_bf16(fl[kk2 * 129 + nn], fl[(kk2 + 1) * 129 + nn]); *(unsigned*)(dst + (size_t)(n0 + nn) * K + k0 + kk2) = w; }
    __syncthreads();
}

__device__ __forceinline__ void ln_phase(float* XZ, bf16_t* H, float* out, const float* g, const float* b, const float* modn, bool is_final, int Mrows, int gw, int ngw, int lane) {
    for (int row = gw; row < Mrows; row += ngw) {
        const f32x4* zr = (const f32x4*)(XZ + (size_t)row * 1024) + lane;
        f32x4 v[4]; float s = 0.f;
#pragma unroll
        for (int j = 0; j < 4; ++j) { v[j] = zr[64 * j]; s += (v[j][0] + v[j][1]) + (v[j][2] + v[j][3]); }
        const float mean = wave_sum(s) * (1.0f / 1024.0f); float s2 = 0.f;
#pragma unroll
        for (int j = 0; j < 4; ++j) { v[j] = v[j] - mean; s2 += (v[j][0] * v[j][0] + v[j][1] * v[j][1]) + (v[j][2] * v[j][2] + v[j][3] * v[j][3]); }
        const float rstd = 1.0f / sqrtf(wave_sum(s2) * (1.0f / 1024.0f) + 1e-5f);
        const int mi = row < ML ? (row >> 11) : 8;
#pragma unroll
        for (int j = 0; j < 4; ++j) {
            const int col = 256 * j + 4 * lane;
            const f32x4 gg = *(const f32x4*)(g + col), bb = *(const f32x4*)(b + col);
            const f32x4 xv = v[j] * rstd * gg + bb;
            if (is_final) { *(f32x4*)(out + (size_t)row * 1024 + col) = xv; }
            else {
                *(f32x4*)(XZ + (size_t)row * 1024 + col) = xv;
                const f32x4 sh = *(const f32x4*)(modn + (size_t)mi * MODLD + col), sc = *(const f32x4*)(modn + (size_t)mi * MODLD + 1024 + col);
                const f32x4 hv = xv * (sc + 1.0f) + sh;
                u32x2 w; w.x = cvt_pk_bf16(hv[0], hv[1]); w.y = cvt_pk_bf16(hv[2], hv[3]);
                *(u32x2*)(H + (size_t)row * 1024 + col) = w;
            }
        }
    }
}

__device__ __forceinline__ void attn_phase(const bf16_t* QK, const bf16_t* VT, bf16_t* O, const float* rpb, bool need_ctx, LAS float* btab, int gw, int ngw, int lane) {
    const int fr = lane & 15, fq = lane >> 4;
    const int nunits = 4096 + (need_ctx ? 512 : 0);
    const float SC2 = 0.125f * LOG2E;
    for (int u = gw; u < nunits; u += ngw) {
        int b, h, r, r0, tq0, nloc;
        if (u < 4096) { r = u & 31; h = (u >> 5) & 15; b = u >> 9; r0 = min(max(r - 4, 0), 24); tq0 = b * SEQ + r * 64; nloc = 16; }
        else { const int v = u - 4096; const int qc4 = v & 3; h = (v >> 2) & 15; b = v >> 6; r = 0; r0 = 0; tq0 = ML + b * CTXL + qc4 * 64; nloc = 0; }
        const int tk0 = b * SEQ + r0 * 64, tc0 = ML + b * CTXL;
        asm volatile("s_waitcnt lgkmcnt(0)" ::: "memory");
        for (int i = lane; i < 465; i += 64) btab[i] = rpb[h * 465 + i] * LOG2E;
        asm volatile("s_waitcnt lgkmcnt(0)" ::: "memory");
        bf16x8 bq[4][2];
#pragma unroll
        for (int qt = 0; qt < 4; ++qt)
#pragma unroll
            for (int ks = 0; ks < 2; ++ks) bq[qt][ks] = *(const bf16x8*)(QK + (size_t)(tq0 + 16 * qt + fr) * 2048 + h * 64 + 32 * ks + 8 * fq);
        f32x4 oacc[4][4];
#pragma unroll
        for (int dt = 0; dt < 4; ++dt)
#pragma unroll
            for (int qt = 0; qt < 4; ++qt) oacc[dt][qt] = (f32x4){0.f, 0.f, 0.f, 0.f};
        float mrun[4], lsum[4];
#pragma unroll
        for (int qt = 0; qt < 4; ++qt) { mrun[qt] = -1e29f; lsum[qt] = 0.f; }
        const int nsteps = nloc + 8;
        for (int s = 0; s < nsteps; ++s) {
            const bool loc = s < nloc;
            const int kt = loc ? tk0 + 32 * s : tc0 + 32 * (s - nloc);
            bf16x8 ak[2][2];
#pragma unroll
            for (int kt2 = 0; kt2 < 2; ++kt2)
#pragma unroll
                for (int ks = 0; ks < 2; ++ks) ak[kt2][ks] = *(const bf16x8*)(QK + (size_t)(kt + 16 * kt2 + fr) * 2048 + 1024 + h * 64 + 32 * ks + 8 * fq);
            bf16x8 av[4];
#pragma unroll
            for (int dt = 0; dt < 4; ++dt) { const bf16_t* vp = VT + (size_t)(h * 64 + 16 * dt + fr) * MT + kt + 4 * fq;
                const u32x2 lo = *(const u32x2*)vp, hi = *(const u32x2*)(vp + 16); u32x4 t4; t4.x = lo.x; t4.y = lo.y; t4.z = hi.x; t4.w = hi.y; av[dt] = __builtin_bit_cast(bf16x8, t4); }
            f32x4 sacc[2][4];
#pragma unroll
            for (int kt2 = 0; kt2 < 2; ++kt2)
#pragma unroll
                for (int qt = 0; qt < 4; ++qt) { f32x4 a = (f32x4){0.f, 0.f, 0.f, 0.f}; a = mfma16(ak[kt2][0], bq[qt][0], a); a = mfma16(ak[kt2][1], bq[qt][1], a); sacc[kt2][qt] = a; }
            if (loc) {
                const int jj = s >> 1, drow = r0 + jj - r + 7, kcb = (32 * s) & 63;
#pragma unroll
                for (int qt = 0; qt < 4; ++qt) {
                    const int qc = 16 * qt + fr, cs = min(max(qc - 8, 0), 48);
#pragma unroll
                    for (int kt2 = 0; kt2 < 2; ++kt2)
#pragma unroll
                        for (int j = 0; j < 4; ++j) { const int kc = kcb + 16 * kt2 + 4 * fq + j; const bool in = (kc >= cs) && (kc < cs + 16);
                            const int dcol = min(max(kc - qc + 15, 0), 30);
                            const float bias = btab[drow * 31 + dcol];
                            sacc[kt2][qt][j] = in ? (sacc[kt2][qt][j] * SC2 + bias) : -1e30f; }
                }
            } else {
#pragma unroll
                for (int qt = 0; qt < 4; ++qt)
#pragma unroll
                    for (int kt2 = 0; kt2 < 2; ++kt2) sacc[kt2][qt] = sacc[kt2][qt] * SC2;
            }
            bf16x8 bp[4];
#pragma unroll
            for (int qt = 0; qt < 4; ++qt) {
                float tm = fmaxf(fmaxf(fmaxf(sacc[0][qt][0], sacc[0][qt][1]), fmaxf(sacc[0][qt][2], sacc[0][qt][3])), fmaxf(fmaxf(sacc[1][qt][0], sacc[1][qt][1]), fmaxf(sacc[1][qt][2], sacc[1][qt][3])));
                tm = fmaxf(tm, __shfl_xor(tm, 16)); tm = fmaxf(tm, __shfl_xor(tm, 32));
                const float mnew = fmaxf(mrun[qt], tm), alpha = __builtin_amdgcn_exp2f(mrun[qt] - mnew);
                mrun[qt] = mnew;
                float pv[8], ps = 0.f;
#pragma unroll
                for (int kt2 = 0; kt2 < 2; ++kt2)
#pragma unroll
                    for (int j = 0; j < 4; ++j) { pv[kt2 * 4 + j] = __builtin_amdgcn_exp2f(sacc[kt2][qt][j] - mnew); ps += pv[kt2 * 4 + j]; }
                lsum[qt] = lsum[qt] * alpha + ps;
#pragma unroll
                for (int dt = 0; dt < 4; ++dt) oacc[dt][qt] = oacc[dt][qt] * alpha;
                u32x4 t4; t4.x = cvt_pk_bf16(pv[0], pv[1]); t4.y = cvt_pk_bf16(pv[2], pv[3]); t4.z = cvt_pk_bf16(pv[4], pv[5]); t4.w = cvt_pk_bf16(pv[6], pv[7]);
                bp[qt] = __builtin_bit_cast(bf16x8, t4);
            }
#pragma unroll
            for (int dt = 0; dt < 4; ++dt)
#pragma unroll
                for (int qt = 0; qt < 4; ++qt) oacc[dt][qt] = mfma16(av[dt], bp[qt], oacc[dt][qt]);
        }
#pragma unroll
        for (int qt = 0; qt < 4; ++qt) {
            float l = lsum[qt]; l += __shfl_xor(l, 16); l += __shfl_xor(l, 32);
            const float inv = 1.0f / l;
#pragma unroll
            for (int dt = 0; dt < 4; ++dt) { const f32x4 v = oacc[dt][qt] * inv; u32x2 w; w.x = cvt_pk_bf16(v[0], v[1]); w.y = cvt_pk_bf16(v[2], v[3]);
                *(u32x2*)(O + (size_t)(tq0 + 16 * qt + fr) * 1024 + h * 64 + 16 * dt + 4 * fq) = w; }
        }
    }
}

__device__ __forceinline__ void lru_gates_phase(const bf16_t* UC, const bf16_t* WG, const float* bgates, const float* lam, bf16_t* LAB, LAS unsigned char* lds, int c, int G, int tid) {
    const int wid = tid >> 6, lane = tid & 63, fr = lane & 15, fq = lane >> 4;
    LAS float* tab_sp = (LAS float*)(lds + 79872);
    LAS float* tab_b = (LAS float*)(lds + 79872 + 768);
    for (int u = c; u < 256; u += G) {
        const int nb = u & 15, chunk = u >> 4;
        for (int i = tid; i < 4608; i += 512) { const int row = i / 12, pc = i - row * 12; const u32x4 v = *(const u32x4*)(WG + ((size_t)nb * 384 + row) * 96 + pc * 8); *(LAS u32x4*)(lds + row * 208 + pc * 16) = v; }
        if (tid < 192) { const int d = tid / 96, jl = tid - d * 96; float v = 0.f; if (jl < 88) { const float lm = lam[d * DRNN + nb * 88 + jl]; v = 8.0f * log1pf(__expf(-lm)); } tab_sp[tid] = v; }
        else if (tid < 576) { const int t2 = tid - 192, q = t2 / 96, jl = t2 - q * 96; tab_b[t2] = (jl < 88) ? bgates[q * DRNN + nb * 88 + jl] : 0.f; }
        __syncthreads();
        for (int it = 0; it < 9; ++it) {
            const int row0 = chunk * 1152 + (it * 8 + wid) * 16;
            bf16x8 bu[3];
#pragma unroll
            for (int ks = 0; ks < 3; ++ks) bu[ks] = *(const bf16x8*)(UC + (size_t)(row0 + fr) * DRNN + nb * 88 + ks * 32 + fq * 8);
            f32x4 acc[4][6];
#pragma unroll
            for (int q = 0; q < 4; ++q)
#pragma unroll
                for (int jt = 0; jt < 6; ++jt) { f32x4 a = (f32x4){0.f, 0.f, 0.f, 0.f};
#pragma unroll
                    for (int ks = 0; ks < 3; ++ks) { const bf16x8 aw = *(const LAS bf16x8*)(lds + (q * 96 + 16 * jt + fr) * 208 + (ks * 32 + fq * 8) * 2); a = mfma16(aw, bu[ks], a); }
                    acc[q][jt] = a; }
#pragma unroll
            for (int jt = 0; jt < 6; ++jt) {
                if (jt < 5 || fq < 2) {
                    const int cl = 16 * jt + 4 * fq; const size_t off = (size_t)(row0 + fr) * DRNN + nb * 88 + cl;
                    const u32x2 ur = *(const u32x2*)(UC + off);
                    float uu[4]; uu[0] = bflo(ur.x); uu[1] = bfhi(ur.x); uu[2] = bflo(ur.y); uu[3] = bfhi(ur.y);
#pragma unroll
                    for (int d = 0; d < 2; ++d) {
                        float la[4], bb[4];
#pragma unroll
                        for (int j = 0; j < 4; ++j) {
                            const float gr = acc[2 * d][jt][j] + tab_b[(2 * d) * 96 + cl + j], gi = acc[2 * d + 1][jt][j] + tab_b[(2 * d + 1) * 96 + cl + j];
                            const float rr = pg8::fast_sigmoid(gr), ii = pg8::fast_sigmoid(gi);
                            const float l = -rr * tab_sp[d * 96 + cl + j];
                            const float a2 = __expf(2.0f * l);
                            la[j] = l; bb[j] = sqrtf(fmaxf(1.0f - a2, 0.f)) * ii * uu[j];
                        }
                        u32x2 w0, w1; w0.x = cvt_pk_bf16(la[0], la[1]); w0.y = cvt_pk_bf16(la[2], la[3]); w1.x = cvt_pk_bf16(bb[0], bb[1]); w1.y = cvt_pk_bf16(bb[2], bb[3]);
                        *(u32x2*)(LAB + (size_t)(2 * d) * MT * DRNN + off) = w0;
                        *(u32x2*)(LAB + (size_t)(2 * d + 1) * MT * DRNN + off) = w1;
                    }
                }
            }
        }
        __syncthreads();
    }
}

__device__ __forceinline__ int scan_row(int b, int p, bool rev) {
    if (!rev) return p < CTXL ? ML + b * CTXL + p : b * SEQ + (p - CTXL);
    return p < CTXL ? ML + b * CTXL + (CTXL - 1 - p) : b * SEQ + (SEQ - 1 - (p - CTXL));
}
template <bool P2, bool REV>
__device__ __forceinline__ void scan_chunk(const bf16_t* LA, const bf16_t* BB, const bf16_t* GATE, bf16_t* YF, bf16_t* YIN, int b, int ch, int p0, float& h, float& sl) {
    constexpr int NBT = 8;
    float laA[NBT], bbA[NBT], ggA[NBT], yfA[NBT], laB[NBT], bbB[NBT], ggB[NBT], yfB[NBT];
#define SC_LOAD(la, bb, gg, yf, t0) _Pragma("unroll") for (int i = 0; i < NBT; ++i) { const size_t o = (size_t)scan_row(b, p0 + (t0) + i, REV) * DRNN + ch; \
        la[i] = bf2f(LA[o]); bb[i] = bf2f(BB[o]); if (P2 && REV) { gg[i] = bf2f(GATE[o]); yf[i] = bf2f(YF[o]); } }
#define SC_COMP(la, bb, gg, yf, t0) _Pragma("unroll") for (int i = 0; i < NBT; ++i) { h = __expf(la[i]) * h + bb[i]; if (!P2) sl += la[i]; \
        if (P2) { const size_t o = (size_t)scan_row(b, p0 + (t0) + i, REV) * DRNN + ch; if (REV) YIN[o] = f2bf(gg[i] * (yf[i] + h)); else YF[o] = f2bf(h); } }
    SC_LOAD(laA, bbA, ggA, yfA, 0);
    for (int t0 = 0; t0 < 288; t0 += 2 * NBT) {
        SC_LOAD(laB, bbB, ggB, yfB, t0 + NBT);
        SC_COMP(laA, bbA, ggA, yfA, t0);
        if (t0 + 2 * NBT < 288) { SC_LOAD(laA, bbA, ggA, yfA, t0 + 2 * NBT); }
        SC_COMP(laB, bbB, ggB, yfB, t0 + NBT);
    }
#undef SC_LOAD
#undef SC_COMP
}
enum { OP_FFN_IN = 0, OP_FFN_OUT, OP_LN_FFN, OP_LN_MIX, OP_QK, OP_VT, OP_ATT, OP_NA_O, OP_LIN, OP_CONV4, OP_GATES, OP_SCAN, OP_LOUT, OP_SIN, OP_CONV3, OP_SOUT };
struct Op { int op, l, s, sync; };
__constant__ Op PROG[] = {
    {OP_FFN_IN, 0, 0, 1}, {OP_FFN_OUT, 0, 0, 1}, {OP_LN_FFN, 0, 0, 1},
    {OP_QK, 0, 0, 0}, {OP_VT, 0, 0, 1}, {OP_ATT, 0, 0, 1}, {OP_NA_O, 0, 0, 1}, {OP_LN_MIX, 0, 0, 1},
    {OP_FFN_IN, 0, 1, 1}, {OP_FFN_OUT, 0, 1, 1}, {OP_LN_FFN, 0, 1, 1},
    {OP_FFN_IN, 1, 0, 1}, {OP_FFN_OUT, 1, 0, 1}, {OP_LN_FFN, 1, 0, 1},
    {OP_LIN, 1, 0, 1}, {OP_CONV4, 1, 0, 1}, {OP_GATES, 1, 0, 1}, {OP_SCAN, 1, 0, 1}, {OP_LOUT, 1, 0, 1}, {OP_LN_MIX, 1, 0, 1},
    {OP_FFN_IN, 1, 1, 1}, {OP_FFN_OUT, 1, 1, 1}, {OP_LN_FFN, 1, 1, 1},
    {OP_FFN_IN, 2, 0, 1}, {OP_FFN_OUT, 2, 0, 1}, {OP_LN_FFN, 2, 0, 1},
    {OP_SIN, 2, 0, 1}, {OP_CONV3, 2, 0, 1}, {OP_SOUT, 2, 0, 1}, {OP_LN_MIX, 2, 0, 1},
    {OP_FFN_IN, 2, 1, 1}, {OP_FFN_OUT, 2, 1, 1}, {OP_LN_FFN, 2, 1, 1},
    {OP_FFN_IN, 3, 0, 1}, {OP_FFN_OUT, 3, 0, 1}, {OP_LN_FFN, 3, 0, 1},
    {OP_QK, 3, 0, 0}, {OP_VT, 3, 0, 1}, {OP_ATT, 3, 0, 1}, {OP_NA_O, 3, 0, 1}, {OP_LN_MIX, 3, 0, 1},
    {OP_FFN_IN, 3, 1, 1}, {OP_FFN_OUT, 3, 1, 1}, {OP_LN_FFN, 3, 1, 0},
};
constexpr int NPROG = sizeof(PROG) / sizeof(Op);

__global__ void __launch_bounds__(512, 2) fwd_kernel(Params p) {
    extern __shared__ __attribute__((aligned(16))) unsigned char smem[];
    cg::grid_group grid = cg::this_grid();
    LAS unsigned char* lds = (LAS unsigned char*)smem;
    const int G = gridDim.x, c = blockIdx.x;
    unsigned char* ws = p.ws;
    {
        const int tid = threadIdx.x;
        const int gtid = c * 512 + tid, ngt = G * 512;
        bf16_t* W_G = (bf16_t*)(ws + OFF_W_G); float* MOD = (float*)(ws + OFF_MOD);
        LAS float* fl = (LAS float*)lds;
        constexpr int NT = 8 * 704 + 8 * 352 + 2 * 256 + 2 * 128 + 2 * 128 + 352 + 176 + 384 + 128;
        for (int u = c; u < NT; u += G) {
            int r = u; const float* src; size_t doff; int ld, col0 = 0, K = 1024, N, base = 1 << 30, Hh = 0;
            if (r < 8 * 704) { const int j = r / 704; r -= j * 704; src = p.ffn_w_in + (size_t)j * 1024 * 5632; doff = OFF_W_FFN_IN + (size_t)j * SZ_FFN_IN; ld = 5632; N = 5632; base = 0; Hh = 2816; }
            else if ((r -= 8 * 704) < 8 * 352) { const int j = r / 352; r -= j * 352; src = p.ffn_w_out + (size_t)j * 2816 * 1024; doff = OFF_W_FFN_OUT + (size_t)j * SZ_FFN_OUT; ld = 1024; N = 1024; K = 2816; }
            else if ((r -= 8 * 352) < 2 * 256) { const int j = r / 256; r -= j * 256; src = p.na_w_qkv + (size_t)j * 1024 * 3072; doff = OFF_W_QK + (size_t)j * 2048 * 1024 * 2; ld = 3072; N = 2048; }
            else if ((r -= 2 * 256) < 2 * 128) { const int j = r / 128; r -= j * 128; src = p.na_w_qkv + (size_t)j * 1024 * 3072; doff = OFF_W_V + (size_t)j * 1024 * 1024 * 2; ld = 3072; N = 1024; col0 = 2048; }
            else if ((r -= 2 * 128) < 2 * 128) { const int j = r / 128; r -= j * 128; src = p.na_w_o + (size_t)j * 1024 * 1024; doff = OFF_W_O + (size_t)j * 1024 * 1024 * 2; ld = 1024; N = 1024; }
            else if ((r -= 2 * 128) < 352) { src = p.lru_w_in; doff = OFF_W_LIN; ld = 2816; N = 2816; }
            else if ((r -= 352) < 176) { src = p.lru_w_out; doff = OFF_W_LOUT; ld = 1024; N = 1024; K = 1408; }
            else if ((r -= 176) < 384) { src = p.sc_w_in; doff = OFF_W_SIN; ld = 3072; N = 3072; base = 1024; Hh = 1024; }
            else { r -= 384; src = p.sc_w_out; doff = OFF_W_SOUT; ld = 1024; N = 1024; }
            conv_tile(src, ld, col0, K, N, base, Hh, (bf16_t*)(ws + doff), r, fl, tid);
        }
        for (int i = gtid; i < 16 * 384 * 96; i += ngt) {
            const int k = i % 96, rj = (i / 96) % 384, nb = i / (96 * 384), q = rj / 96, j = rj - q * 96;
            float v = 0.f; if (j < 88 && k < 88) v = p.lru_wg[(((size_t)q * 16 + nb) * 88 + k) * 88 + j];
            W_G[i] = f2bf(v);
        }
        LAS float* scnd = (LAS float*)lds;
        LAS float* red = (LAS float*)(lds + 36864);
        __syncthreads();
        for (int i = tid; i < 9216; i += 512) { const float v = (i < 8192) ? p.c[i] : p.c_ctx[i - 8192]; scnd[i] = pg8::silu_f(v); }
        __syncthreads();
        for (int u = c; u < 576; u += G) {
            const int l = u / 144, n0 = (u - l * 144) * 64, col = tid & 63, kg = tid >> 6;
            const float* w = p.mod_w + (size_t)l * 1024 * MODLD + n0 + col;
            float a9[9];
#pragma unroll
            for (int i = 0; i < 9; ++i) a9[i] = 0.f;
#pragma unroll 8
            for (int k = kg * 128; k < kg * 128 + 128; ++k) { const float wv = w[(size_t)k * MODLD];
#pragma unroll
                for (int i = 0; i < 9; ++i) a9[i] += scnd[i * 1024 + k] * wv; }
#pragma unroll
            for (int i = 0; i < 9; ++i) red[(kg * 9 + i) * 64 + col] = a9[i];
            __syncthreads();
            for (int idx = tid; idx < 576; idx += 512) { const int i = idx >> 6, cc = idx & 63; float s = p.mod_b[l * MODLD + n0 + cc];
#pragma unroll
                for (int k2 = 0; k2 < 8; ++k2) s += red[(k2 * 9 + i) * 64 + cc];
                MOD[((size_t)l * 9 + i) * MODLD + n0 + cc] = s; }
            __syncthreads();
        }
    }
    grid.sync();
    {
        const int tid = threadIdx.x, wid = tid >> 6, lane = tid & 63;
        float* MOD = (float*)(ws + OFF_MOD); float* XZ = (float*)(ws + OFF_XZ); bf16_t* H = (bf16_t*)(ws + OFF_H);
        for (int row = c * 8 + wid; row < MT; row += G * 8) {
            const float* srow = row < ML ? p.x + (size_t)row * 1024 : p.ctx + (size_t)(row - ML) * 1024;
            const int mi = row < ML ? (row >> 11) : 8;
#pragma unroll
            for (int j = 0; j < 4; ++j) { const int col = 256 * j + 4 * lane; const f32x4 v = *(const f32x4*)(srow + col);
                *(f32x4*)(XZ + (size_t)row * 1024 + col) = v;
                const f32x4 sh = *(const f32x4*)(MOD + (size_t)mi * MODLD + col), sc = *(const f32x4*)(MOD + (size_t)mi * MODLD + 1024 + col);
                const f32x4 hv = v * (sc + 1.0f) + sh; u32x2 w; w.x = cvt_pk_bf16(hv[0], hv[1]); w.y = cvt_pk_bf16(hv[2], hv[3]);
                *(u32x2*)(H + (size_t)row * 1024 + col) = w; }
        }
    }
    grid.sync();

    for (int pc = 0; pc < NPROG; ++pc) {
        const int op = PROG[pc].op, l = PROG[pc].l, s = PROG[pc].s, dosync = PROG[pc].sync;
        int tidv = threadIdx.x; asm volatile("" : "+v"(tidv));
        const int tid = tidv, wid = tid >> 6, lane = tid & 63;
        const int gw = c * 8 + wid, ngw = G * 8, gtid = c * 512 + tid, ngt = G * 512;
        float* MOD = (float*)(ws + OFF_MOD); float* XZ = (float*)(ws + OFF_XZ);
        bf16_t* H = (bf16_t*)(ws + OFF_H); bf16_t* ACT = (bf16_t*)(ws + OFF_ACT); bf16_t* UCONV = (bf16_t*)(ws + OFF_UCONV); bf16_t* LAB = (bf16_t*)(ws + OFF_LAB);
        const float* MODL = MOD + (size_t)l * 9 * MODLD;
        const int Mff = (l == 3 && s == 1) ? ML : MT;
        const int Mmix = (l == 3) ? ML : MT;
        const int idx = l / 3;
        switch (op) {
        case OP_FFN_IN: case OP_SIN: {
            pg8::Gemm g; pg8::EpiPair E;
            if (op == OP_FFN_IN) { g = pg8::Gemm{H, (const bf16_t*)(ws + OFF_W_FFN_IN + (size_t)(l * 2 + s) * SZ_FFN_IN), Mff, 5632, 1024}; E = pg8::EpiPair{ACT, ACT, DFF, DFF, 0}; }
            else { g = pg8::Gemm{H, (const bf16_t*)(ws + OFF_W_SIN), MT, 3072, 1024}; E = pg8::EpiPair{ACT, ACT + (size_t)MT * 1024, 1024, 1024, 1}; }
            pg8::StaticOrder S; S.init(g.M, g.N, G, c);
            pg8::gemm_phase<pg8::EpiPair, pg8::StaticOrder, true, true>(lds, g, S, E);
        } break;
        case OP_QK: case OP_VT: case OP_LIN: {
            pg8::Gemm g; pg8::EpiSplit E; int cc = c;
            if (op == OP_QK) { g = pg8::Gemm{H, (const bf16_t*)(ws + OFF_W_QK + (size_t)idx * 2048 * 1024 * 2), MT, 2048, 1024}; E = pg8::EpiSplit{ACT, ACT, 1 << 30, 2048, 2048, 0}; }
            else if (op == OP_VT) { bf16_t* VT = ACT + (size_t)MT * 2048; g = pg8::Gemm{(const bf16_t*)(ws + OFF_W_V + (size_t)idx * 1024 * 1024 * 2), H, 1024, MT, 1024}; E = pg8::EpiSplit{VT, VT, 1 << 30, MT, MT, 0}; cc = (c + 192) % G; }
            else { g = pg8::Gemm{H, (const bf16_t*)(ws + OFF_W_LIN), MT, 2816, 1024}; E = pg8::EpiSplit{ACT, ACT + (size_t)MT * DRNN, DRNN, DRNN, DRNN, 1}; }
            pg8::StaticOrder S; S.init(g.M, g.N, G, cc);
            pg8::gemm_phase<pg8::EpiSplit, pg8::StaticOrder, true, true>(lds, g, S, E);
        } break;
        case OP_FFN_OUT: case OP_NA_O: case OP_LOUT: case OP_SOUT: {
            pg8::Gemm g; pg8::EpiRes E;
            if (op == OP_FFN_OUT) { g = pg8::Gemm{ACT, (const bf16_t*)(ws + OFF_W_FFN_OUT + (size_t)(l * 2 + s) * SZ_FFN_OUT), Mff, 1024, 2816}; E = pg8::EpiRes{XZ, MODL + (s == 0 ? 2 : 8) * 1024, 0.5f}; }
            else if (op == OP_NA_O) { g = pg8::Gemm{H, (const bf16_t*)(ws + OFF_W_O + (size_t)idx * 1024 * 1024 * 2), Mmix, 1024, 1024}; E = pg8::EpiRes{XZ, MODL + 5 * 1024, 1.0f}; }
            else if (op == OP_LOUT) { g = pg8::Gemm{UCONV, (const bf16_t*)(ws + OFF_W_LOUT), Mmix, 1024, DRNN}; E = pg8::EpiRes{XZ, MODL + 5 * 1024, 1.0f}; }
            else { g = pg8::Gemm{ACT + (size_t)2 * MT * 1024, (const bf16_t*)(ws + OFF_W_SOUT), Mmix, 1024, 1024}; E = pg8::EpiRes{XZ, MODL + 5 * 1024, 1.0f}; }
            pg8::StaticOrder S; S.init(g.M, g.N, G, c);
            pg8::gemm_phase<pg8::EpiRes, pg8::StaticOrder, true, true>(lds, g, S, E);
        } break;
        case OP_LN_FFN: {
            const bool fin = (l == 3 && s == 1);
            const int j3 = (s == 0) ? 0 : 2;
            const float* modn = fin ? MOD : ((s == 0) ? (MODL + 3 * 1024) : (MOD + (size_t)(l + 1) * 9 * MODLD));
            ln_phase(XZ, H, p.out, p.ln_g + (l * 3 + j3) * 1024, p.ln_b + (l * 3 + j3) * 1024, modn, fin, Mff, gw, ngw, lane);
        } break;
        case OP_LN_MIX: {
            ln_phase(XZ, H, p.out, p.ln_g + (l * 3 + 1) * 1024, p.ln_b + (l * 3 + 1) * 1024, MODL + 6 * 1024, false, Mmix, gw, ngw, lane);
        } break;
        case OP_ATT: {
            attn_phase(ACT, ACT + (size_t)MT * 2048, H, p.na_rpb + (size_t)idx * 16 * 465, l < 3, (LAS float*)lds + wid * 480, gw, ngw, lane);
        } break;
        case OP_CONV4: {
            const bf16_t* U = ACT + (size_t)MT * DRNN;
            for (int it = gtid; it < MT * 176; it += ngt) {
                const int row = it / 176, c0 = (it - row * 176) * 8;
                int sq, len; if (row < ML) { sq = row & 2047; len = SEQ; } else { sq = (row - ML) & 255; len = CTXL; }
                float a8[8];
                { const f32x4 b0 = *(const f32x4*)(p.lru_conv_b + c0), b1 = *(const f32x4*)(p.lru_conv_b + c0 + 4);
                  a8[0] = b0[0]; a8[1] = b0[1]; a8[2] = b0[2]; a8[3] = b0[3]; a8[4] = b1[0]; a8[5] = b1[1]; a8[6] = b1[2]; a8[7] = b1[3]; }
#pragma unroll
                for (int k = 0; k < 4; ++k) { const int t = sq + k - 2;
                    if (t >= 0 && t < len) { const u32x4 uv = *(const u32x4*)(U + (size_t)(row + k - 2) * DRNN + c0);
                        const f32x4 w0 = *(const f32x4*)(p.lru_conv_w + k * DRNN + c0), w1 = *(const f32x4*)(p.lru_conv_w + k * DRNN + c0 + 4);
                        a8[0] += w0[0] * bflo(uv.x); a8[1] += w0[1] * bfhi(uv.x); a8[2] += w0[2] * bflo(uv.y); a8[3] += w0[3] * bfhi(uv.y);
                        a8[4] += w1[0] * bflo(uv.z); a8[5] += w1[1] * bfhi(uv.z); a8[6] += w1[2] * bflo(uv.w); a8[7] += w1[3] * bfhi(uv.w); } }
                u32x4 o; o.x = cvt_pk_bf16(a8[0], a8[1]); o.y = cvt_pk_bf16(a8[2], a8[3]); o.z = cvt_pk_bf16(a8[4], a8[5]); o.w = cvt_pk_bf16(a8[6], a8[7]);
                *(u32x4*)(UCONV + (size_t)row * DRNN + c0) = o;
            }
        } break;
        case OP_GATES: {
            lru_gates_phase(UCONV, (const bf16_t*)(ws + OFF_W_G), p.lru_bg, p.lru_lam, LAB, lds, c, G, tid);
        } break;
        case OP_SCAN: {
            bf16_t* GATE = ACT; bf16_t* U = ACT + (size_t)MT * DRNN;
            LAS float* SA = (LAS float*)lds; LAS float* SB = SA + 512;
            const size_t PL = (size_t)MT * DRNN;
            for (int item = c; item < 176; item += G) {
                const int b = item / 22, ch = (item - b * 22) * 64 + lane, p0 = wid * 288;
                {
                    float hl = 0.f, sl = 0.f;
                    scan_chunk<false, false>(LAB, LAB + PL, GATE, U, UCONV, b, ch, p0, hl, sl);
                    SA[wid * 64 + lane] = sl; SB[wid * 64 + lane] = hl;
                    __syncthreads();
                    float h = 0.f;
                    for (int k = 0; k < wid; ++k) h = __expf(SA[k * 64 + lane]) * h + SB[k * 64 + lane];
                    __syncthreads();
                    scan_chunk<true, false>(LAB, LAB + PL, GATE, U, UCONV, b, ch, p0, h, sl);
                    __syncthreads();
                }
                {
                    float hl = 0.f, sl = 0.f;
                    scan_chunk<false, true>(LAB + 2 * PL, LAB + 3 * PL, GATE, U, UCONV, b, ch, p0, hl, sl);
                    SA[wid * 64 + lane] = sl; SB[wid * 64 + lane] = hl;
                    __syncthreads();
                    float h = 0.f;
                    for (int k = 0; k < wid; ++k) h = __expf(SA[k * 64 + lane]) * h + SB[k * 64 + lane];
                    __syncthreads();
                    scan_chunk<true, true>(LAB + 2 * PL, LAB + 3 * PL, GATE, U, UCONV, b, ch, p0, h, sl);
                    __syncthreads();
                }
            }
        } break;
        case OP_CONV3: {
            const bf16_t* BG = ACT; const bf16_t* PP = ACT + (size_t)MT * 1024; bf16_t* YIN = ACT + (size_t)2 * MT * 1024;
            for (int it = gtid; it < MT * 128; it += ngt) {
                const int row = it >> 7, c0 = (it & 127) * 8;
                int sq, len; if (row < ML) { sq = row & 2047; len = SEQ; } else { sq = (row - ML) & 255; len = CTXL; }
                float a8[8];
#pragma unroll
                for (int i = 0; i < 8; ++i) a8[i] = 0.f;
#pragma unroll
                for (int k = 0; k < 3; ++k) { const int t = sq + k - 1;
                    if (t >= 0 && t < len) { const u32x4 uv = *(const u32x4*)(PP + (size_t)(row + k - 1) * 1024 + c0);
                        const f32x4 w0 = *(const f32x4*)(p.sc_conv_w + k * 1024 + c0), w1 = *(const f32x4*)(p.sc_conv_w + k * 1024 + c0 + 4);
                        a8[0] += w0[0] * bflo(uv.x); a8[1] += w0[1] * bfhi(uv.x); a8[2] += w0[2] * bflo(uv.y); a8[3] += w0[3] * bfhi(uv.y);
                        a8[4] += w1[0] * bflo(uv.z); a8[5] += w1[1] * bfhi(uv.z); a8[6] += w1[2] * bflo(uv.w); a8[7] += w1[3] * bfhi(uv.w); } }
                const u32x4 bv = *(const u32x4*)(BG + (size_t)row * 1024 + c0);
                u32x4 o; o.x = cvt_pk_bf16(a8[0] * bflo(bv.x), a8[1] * bfhi(bv.x)); o.y = cvt_pk_bf16(a8[2] * bflo(bv.y), a8[3] * bfhi(bv.y));
                o.z = cvt_pk_bf16(a8[4] * bflo(bv.z), a8[5] * bfhi(bv.z)); o.w = cvt_pk_bf16(a8[6] * bflo(bv.w), a8[7] * bfhi(bv.w));
                *(u32x4*)(YIN + (size_t)row * 1024 + c0) = o;
            }
        } break;
        default: break;
        }
        if (dosync) grid.sync();
    }
}

extern "C" void kernel_launch(void* const* d_in, const int* in_sizes, int n_in, void* d_out, int out_size, void* d_ws, size_t ws_size, hipStream_t stream) {
    static int grid_blocks = 0;
    if (grid_blocks == 0) {
        if (n_in != 23 || ws_size < WS_END) { fprintf(stderr, "kernel_launch: need 23 inputs and %zu bytes of workspace (got %d, %zu)\n", (size_t)WS_END, n_in, ws_size); grid_blocks = -1; return; }
        int dev = 0, cus = 0, per_cu = 0;
        (void)hipGetDevice(&dev);
        (void)hipDeviceGetAttribute(&cus, hipDeviceAttributeMultiprocessorCount, dev);
        if (hipFuncSetAttribute((const void*)fwd_kernel, hipFuncAttributeMaxDynamicSharedMemorySize, LDS_BYTES) != hipSuccess) { fprintf(stderr, "kernel_launch: hipFuncSetAttribute failed\n"); grid_blocks = -1; return; }
        (void)hipOccupancyMaxActiveBlocksPerMultiprocessor(&per_cu, (const void*)fwd_kernel, 512, LDS_BYTES);
        if (per_cu < 1) { fprintf(stderr, "kernel_launch: occupancy query returned %d\n", per_cu); per_cu = 1; }
        (void)hipGetLastError();
        grid_blocks = cus * per_cu;
    }
    if (grid_blocks < 0) return;
    Params p{};
    const float** pp = (const float**)&p;
    for (int i = 0; i < 23; ++i) pp[i] = (const float*)d_in[i];
    p.out = (float*)d_out; p.ws = (unsigned char*)d_ws;
    void* args[] = {&p};
    hipError_t e = hipLaunchCooperativeKernel((const void*)fwd_kernel, dim3(grid_blocks), dim3(512), args, LDS_BYTES, stream);
    if (e != hipSuccess) fprintf(stderr, "cooperative launch failed: %s (grid %d)\n", hipGetErrorString(e), grid_blocks);
}
```

```cpp
#include <hip/hip_runtime.h>
#include <hip/hip_cooperative_groups.h>
#include <cstdio>
#include <cstdint>
namespace cg = cooperative_groups;
namespace pg8 {
#define PG8_LAS __attribute__((address_space(3)))
typedef unsigned short bf16_t;
typedef short bf16x8 __attribute__((ext_vector_type(8)));
typedef float f32x4 __attribute__((ext_vector_type(4)));
typedef unsigned u32x4 __attribute__((ext_vector_type(4)));
constexpr int BM = 256, BK = 64, HALF = 128, HTB = HALF * BK * 2  , STAGE_BYTES = 8 * HTB, NXCD = 8, WGM = 8;

__host__ __device__ __forceinline__ int lds_byte(int r, int c) { const int st = (r >> 4) * 2 + (c >> 5), rr = r & 15, cc = c & 31, ob = rr * 64 + cc * 2; return st * 1024 + (ob ^ (((ob >> 9) & 1) << 5)); }
__host__ __device__ __forceinline__ void stage_rc(int b, int& R, int& C) { const int st = b / 1024, sb = b % 1024, swz = sb ^ (((sb >> 9) & 1) << 5); R = (st >> 1) * 16 + swz / 64; C = (st & 1) * 32 + (swz % 64) / 2; }
__host__ __device__ __forceinline__ int perm32(int rho) { const int n = rho >> 4, i = rho & 15; return 8 * (i >> 2) + 4 * n + (i & 3); }

struct Unit { int pm, pn; };
struct Gemm { const bf16_t* A; const bf16_t* Bt; int M, N, K; };

struct StaticOrder {
    int nM, nN, nwg, G, c;
    __host__ __device__ void init(int M, int N, int G_, int c_) { nM = M / BM; nN = N / BM; nwg = nM * nN; G = G_; c = c_; }
    __host__ __device__ bool next(int i, Unit& u) const {
        const long L = (long)i * G + c; if (L >= nwg) return false;
        int wgid = (int)L; { const int q = nwg / NXCD, r = nwg % NXCD, xcd = wgid % NXCD, off = wgid / NXCD; wgid = (xcd < r ? xcd * (q + 1) : r * (q + 1) + (xcd - r) * q) + off; }
        const int nig = WGM * nN, gid = wgid / nig, fm = gid * WGM, gsz = (nM - fm) < WGM ? (nM - fm) : WGM;
        u.pm = fm + ((wgid % nig) % gsz); u.pn = (wgid % nig) / gsz; return true;
    }
    __device__ __forceinline__ void a_ready(const Unit&) const {}
    __device__ __forceinline__ void done(const Unit&) const {}
};

__device__ __forceinline__ unsigned cvt_pk_bf16(float lo, float hi) { unsigned r; asm volatile("v_cvt_pk_bf16_f32 %0, %1, %2" : "=v"(r) : "v"(lo), "v"(hi)); return r; }
typedef float f32x2 __attribute__((ext_vector_type(2)));
typedef unsigned u32x2 __attribute__((ext_vector_type(2)));
__device__ __forceinline__ float fast_sigmoid(float v) { return __builtin_amdgcn_rcpf(1.0f + __expf(-v)); }
__device__ __forceinline__ float silu_f(float v) { return v * fast_sigmoid(v); }
__device__ __forceinline__ float gelu_tanh_f(float v) { const float y = 0.7978845608028654f * (v + 0.044715f * v * v * v); return v * fast_sigmoid(2.0f * y); }

struct EpiPair {
    static constexpr bool PERM = true, AFTER_DRAIN = false;
    bf16_t* O0; bf16_t* O1; int ld0, ld1; int mode;
    __device__ __forceinline__ void operator()(const f32x4 (&acc)[2][2][4][2], const Unit& u, int wr, int wc, int fr, int fq) const {
        if (mode == 0) body<0>(acc, u, wr, wc, fr, fq); else body<1>(acc, u, wr, wc, fr, fq);
    }
    template <int MODE> __device__ __forceinline__ void body(const f32x4 (&acc)[2][2][4][2], const Unit& u, int wr, int wc, int fr, int fq) const {
        const int row0 = u.pm * BM + wr * 64 + fr;
        if (MODE == 1 && u.pn < 4) {
            const int col0 = u.pn * BM + wc * 32 + 8 * fq;
#pragma unroll
            for (int ai = 0; ai < 2; ++ai)
#pragma unroll
                for (int m = 0; m < 4; ++m) { bf16_t* rowp = O0 + (size_t)(row0 + ai * HALF + m * 16) * ld0 + col0;
#pragma unroll
                    for (int bj = 0; bj < 2; ++bj) { const f32x4 v0 = acc[ai][bj][m][0], v1 = acc[ai][bj][m][1];
                        u32x4 w; w.x = cvt_pk_bf16(v0[0], v0[1]); w.y = cvt_pk_bf16(v0[2], v0[3]); w.z = cvt_pk_bf16(v1[0], v1[1]); w.w = cvt_pk_bf16(v1[2], v1[3]);
                        *(u32x4*)(rowp + bj * HALF) = w; } }
        } else {
            const int pnn = (MODE == 1) ? (u.pn - 4) : u.pn;
            bf16_t* O = (MODE == 1) ? O1 : O0; const int ld = (MODE == 1) ? ld1 : ld0;
            const int col0 = pnn * HALF + wc * 32 + 8 * fq;
#pragma unroll
            for (int ai = 0; ai < 2; ++ai)
#pragma unroll
                for (int m = 0; m < 4; ++m) {
                    float r[8];
#pragma unroll
                    for (int n = 0; n < 2; ++n)
#pragma unroll
                        for (int j = 0; j < 4; ++j) { const float g = acc[ai][0][m][n][j], uu = acc[ai][1][m][n][j]; r[n * 4 + j] = (MODE == 0) ? silu_f(g) * uu : g * uu; }
                    u32x4 w; w.x = cvt_pk_bf16(r[0], r[1]); w.y = cvt_pk_bf16(r[2], r[3]); w.z = cvt_pk_bf16(r[4], r[5]); w.w = cvt_pk_bf16(r[6], r[7]);
                    *(u32x4*)(O + (size_t)(row0 + ai * HALF + m * 16) * ld + col0) = w; }
        }
    }
};
struct EpiSplit {
    static constexpr bool PERM = true, AFTER_DRAIN = false;
    bf16_t* O0; bf16_t* O1; int split, ld0, ld1; int act;
    __device__ __forceinline__ void operator()(const f32x4 (&acc)[2][2][4][2], const Unit& u, int wr, int wc, int fr, int fq) const {
        if (act == 0) body<0>(acc, u, wr, wc, fr, fq); else body<1>(acc, u, wr, wc, fr, fq);
    }
    template <int ACT> __device__ __forceinline__ void body(const f32x4 (&acc)[2][2][4][2], const Unit& u, int wr, int wc, int fr, int fq) const {
        const int row0 = u.pm * BM + wr * 64 + fr;
#pragma unroll
        for (int bj = 0; bj < 2; ++bj) {
            const int cb = u.pn * BM + bj * HALF; const bool second = cb >= split;
            bf16_t* O = second ? O1 : O0; const int ld = second ? ld1 : ld0; const int col0 = (second ? cb - split : cb) + wc * 32 + 8 * fq;
#pragma unroll
            for (int ai = 0; ai < 2; ++ai)
#pragma unroll
                for (int m = 0; m < 4; ++m) { f32x4 v0 = acc[ai][bj][m][0], v1 = acc[ai][bj][m][1];
                    if (ACT == 1 && !second) {
#pragma unroll
                        for (int j = 0; j < 4; ++j) { v0[j] = gelu_tanh_f(v0[j]); v1[j] = gelu_tanh_f(v1[j]); } }
                    u32x4 w; w.x = cvt_pk_bf16(v0[0], v0[1]); w.y = cvt_pk_bf16(v0[2], v0[3]); w.z = cvt_pk_bf16(v1[0], v1[1]); w.w = cvt_pk_bf16(v1[2], v1[3]);
                    *(u32x4*)(O + (size_t)(row0 + ai * HALF + m * 16) * ld + col0) = w; }
        }
    }
};
struct EpiRes {
    static constexpr bool PERM = false, AFTER_DRAIN = false;
    float* XZ; const float* gate; float cmul;
    __device__ __forceinline__ void operator()(const f32x4 (&acc)[2][2][4][2], const Unit& u, int wr, int wc, int fr, int fq) const {
        const int mi = (u.pm < 64) ? (u.pm >> 3) : 8;
        const int row0 = u.pm * BM + wr * 64 + fr, col0 = u.pn * BM + wc * 32 + 4 * fq;
        const float* gp = gate + (size_t)mi * 9216 + col0;
        f32x4 gv[2][2];
#pragma unroll
        for (int bj = 0; bj < 2; ++bj)
#pragma unroll
            for (int n = 0; n < 2; ++n) gv[bj][n] = *(const f32x4*)(gp + bj * HALF + n * 16) * cmul;
#pragma unroll
        for (int ai = 0; ai < 2; ++ai)
#pragma unroll
            for (int m = 0; m < 4; ++m) { float* rowp = XZ + (size_t)(row0 + ai * HALF + m * 16) * 1024 + col0;
#pragma unroll
                for (int bj = 0; bj < 2; ++bj)
#pragma unroll
                    for (int n = 0; n < 2; ++n) { const f32x4 xv = *(const f32x4*)(rowp + bj * HALF + n * 16);
                        *(f32x4*)(rowp + bj * HALF + n * 16) = xv * 1.6817928305074290f + gv[bj][n] * acc[ai][bj][m][n]; } }
    }
};
template <class Epi, class Sched, bool ALIGN_EPI = false, bool SP2 = false>
__device__ __forceinline__ void gemm_phase(PG8_LAS unsigned char* lds, const Gemm g, const Sched& S, const Epi& E) {
    int tidv = threadIdx.x; asm volatile("" : "+v"(tidv)); const int tid = tidv, wid = __builtin_amdgcn_readfirstlane(tid >> 6), lane = tid & 63, wr = wid >> 2, wc = wid & 3, fr = lane & 15, fq = lane >> 4;
    const int K = g.K, nt = K / BK;
    unsigned voffA[2], voffB[2];
#pragma unroll
    for (int i = 0; i < 2; ++i) { int R, C; stage_rc(tid * 16 + i * 8192, R, C); const int Rb = Epi::PERM ? ((R & ~31) + perm32(R & 31)) : R;
        voffA[i] = (unsigned)(R * K + C) * 2u; voffB[i] = (unsigned)(Rb * K + C) * 2u; }
    const size_t kstep = (size_t)(BK * 2);
    const size_t hstep = (size_t)HALF * K * 2;
    const size_t tstep = 2 * hstep;
    const unsigned ldsw = (unsigned)wid * 1024u;
    const int aoff = lds_byte(wr * 64 + fr, fq * 8), boff = lds_byte(wc * 32 + fr, fq * 8);
#define PG8_SA(b, h) (((b) * 2 + (h)) * HTB)
#define PG8_SB(b, h) ((4 + (b) * 2 + (h)) * HTB)
#define PG8_STAGE(bufoff, gbase, voff) do { _Pragma("unroll") for (int _i = 0; _i < 2; ++_i) \
        __builtin_amdgcn_global_load_lds((const unsigned*)((const char*)(gbase) + (voff)[_i]), (PG8_LAS unsigned*)(lds + (bufoff) + ldsw + _i * 8192), 16, 0, 0); } while (0)
#define PG8_LDA(dst, b, h) do { _Pragma("unroll") for (int m = 0; m < 4; ++m) _Pragma("unroll") for (int k = 0; k < 2; ++k) dst[m][k] = *(const PG8_LAS bf16x8*)(lds + PG8_SA(b, h) + aoff + m * 2048 + k * 1024); } while (0)
#define PG8_LDB(dst, b, h) do { _Pragma("unroll") for (int n = 0; n < 2; ++n) _Pragma("unroll") for (int k = 0; k < 2; ++k) dst[n][k] = *(const PG8_LAS bf16x8*)(lds + PG8_SB(b, h) + boff + n * 2048 + k * 1024); } while (0)
#define PG8_MMA(ai, bj, At, Bt) do { __builtin_amdgcn_s_setprio(1); _Pragma("unroll") for (int m = 0; m < 4; ++m) _Pragma("unroll") for (int n = 0; n < 2; ++n) _Pragma("unroll") for (int k = 0; k < 2; ++k) \
        acc[ai][bj][m][n] = __builtin_amdgcn_mfma_f32_16x16x32_bf16(Bt[n][k], At[m][k], acc[ai][bj][m][n], 0, 0, 0); __builtin_amdgcn_s_setprio(0); } while (0)
#define PG8_WAIT_V(n) asm volatile("s_waitcnt vmcnt(" #n ")" ::: "memory")
#define PG8_WAIT_L(n) asm volatile("s_waitcnt lgkmcnt(" #n ")" ::: "memory")
#define PG8_BAR __builtin_amdgcn_s_barrier()
#define PG8_SCHED __builtin_amdgcn_sched_barrier(0)
    Unit cur, nxt; int ui = 0;
    if (!S.next(0, cur)) return;
    f32x4 acc[2][2][4][2];
#pragma unroll
    for (int a = 0; a < 2; ++a)
#pragma unroll
        for (int b = 0; b < 2; ++b)
#pragma unroll
            for (int m = 0; m < 4; ++m)
#pragma unroll
                for (int n = 0; n < 2; ++n) acc[a][b][m][n] = (f32x4){0.f, 0.f, 0.f, 0.f};
    bf16x8 At[4][2], B0[2][2], B1[2][2];
    const char* cA = (const char*)g.A + (size_t)cur.pm * tstep; const char* cB = (const char*)g.Bt + (size_t)cur.pn * tstep;
    S.a_ready(cur);
    if constexpr (SP2) {
        PG8_STAGE(PG8_SB(0, 0), cB, voffB); PG8_STAGE(PG8_SB(0, 1), cB + hstep, voffB); PG8_STAGE(PG8_SA(0, 0), cA, voffA); PG8_STAGE(PG8_SA(0, 1), cA + hstep, voffA);
        if (wr == 1) PG8_BAR;
        PG8_WAIT_V(2); PG8_BAR;
        PG8_STAGE(PG8_SB(1, 0), cB + kstep, voffB); PG8_STAGE(PG8_SA(1, 0), cA + kstep, voffA); PG8_STAGE(PG8_SB(1, 1), cB + hstep + kstep, voffB);
        PG8_WAIT_V(6); PG8_BAR;
    } else {
        PG8_STAGE(PG8_SB(0, 0), cB, voffB); PG8_STAGE(PG8_SA(0, 0), cA, voffA); PG8_STAGE(PG8_SB(0, 1), cB + hstep, voffB); PG8_STAGE(PG8_SA(0, 1), cA + hstep, voffA);
        if (wr == 1) PG8_BAR;
        PG8_WAIT_V(4); PG8_BAR;
        PG8_STAGE(PG8_SB(1, 0), cB + kstep, voffB); PG8_STAGE(PG8_SA(1, 0), cA + kstep, voffA); PG8_STAGE(PG8_SB(1, 1), cB + hstep + kstep, voffB);
        PG8_WAIT_V(6); PG8_BAR;
    }
    for (;;) {
        const bool has_next = S.next(ui + 1, nxt);
        const char* nA = has_next ? (const char*)g.A + (size_t)nxt.pm * tstep : cA; const char* nB = has_next ? (const char*)g.Bt + (size_t)nxt.pn * tstep : cB;
        for (int t = 0; t < nt; t += 2) {
            const bool last = (t == nt - 2);
            const char* a1 = cA + (size_t)(t + 1) * kstep;
            const char* a2 = last ? nA : cA + (size_t)(t + 2) * kstep; const char* b2 = last ? nB : cB + (size_t)(t + 2) * kstep;
            const char* a3 = a2 + kstep; const char* b3 = b2 + kstep;
            if (last && has_next) S.a_ready(nxt);
            if constexpr (SP2) {
            PG8_LDB(B0, 0, 0); PG8_LDB(B1, 0, 1); PG8_SCHED; PG8_LDA(At, 0, 0); PG8_STAGE(PG8_SA(1, 1), a1 + hstep, voffA);
            PG8_WAIT_V(8); PG8_WAIT_L(0); PG8_BAR; PG8_MMA(0, 0, At, B0); PG8_MMA(0, 1, At, B1); PG8_BAR; PG8_SCHED;
            PG8_LDA(At, 0, 1); PG8_STAGE(PG8_SB(0, 0), b2, voffB); PG8_STAGE(PG8_SB(0, 1), b2 + hstep, voffB); PG8_STAGE(PG8_SA(0, 0), a2, voffA);
            PG8_WAIT_V(8); PG8_WAIT_L(0); PG8_BAR; PG8_MMA(1, 0, At, B0); PG8_MMA(1, 1, At, B1); PG8_BAR; PG8_SCHED;
            PG8_LDB(B0, 1, 0); PG8_LDB(B1, 1, 1); PG8_SCHED; PG8_LDA(At, 1, 0); PG8_STAGE(PG8_SA(0, 1), a2 + hstep, voffA);
            PG8_WAIT_V(8); PG8_WAIT_L(0); PG8_BAR; PG8_MMA(0, 0, At, B0); PG8_MMA(0, 1, At, B1); PG8_BAR; PG8_SCHED;
            PG8_LDA(At, 1, 1); PG8_STAGE(PG8_SB(1, 0), b3, voffB); PG8_STAGE(PG8_SB(1, 1), b3 + hstep, voffB); PG8_STAGE(PG8_SA(1, 0), a3, voffA);
            PG8_WAIT_V(8); PG8_WAIT_L(0); PG8_BAR; PG8_MMA(1, 0, At, B0); PG8_MMA(1, 1, At, B1); PG8_BAR; PG8_SCHED;
            } else {
            PG8_LDB(B0, 0, 0); PG8_SCHED; PG8_LDA(At, 0, 0); PG8_STAGE(PG8_SA(1, 1), a1 + hstep, voffA);
            PG8_WAIT_L(8); PG8_BAR; PG8_WAIT_L(0); PG8_MMA(0, 0, At, B0); PG8_BAR; PG8_SCHED;
            PG8_LDB(B1, 0, 1); PG8_STAGE(PG8_SB(0, 0), b2, voffB);
            PG8_BAR; PG8_WAIT_L(0); PG8_MMA(0, 1, At, B1); PG8_BAR;
            PG8_LDA(At, 0, 1); PG8_STAGE(PG8_SA(0, 0), a2, voffA);
            PG8_BAR; PG8_WAIT_L(0); PG8_MMA(1, 0, At, B0); PG8_BAR; PG8_SCHED;
            PG8_STAGE(PG8_SB(0, 1), b2 + hstep, voffB);
            PG8_WAIT_V(6); PG8_BAR; PG8_MMA(1, 1, At, B1); PG8_BAR;
            PG8_LDB(B0, 1, 0); PG8_SCHED; PG8_LDA(At, 1, 0); PG8_STAGE(PG8_SA(0, 1), a2 + hstep, voffA);
            PG8_WAIT_L(8); PG8_BAR; PG8_WAIT_L(0); PG8_MMA(0, 0, At, B0); PG8_BAR; PG8_SCHED;
            PG8_LDB(B1, 1, 1); PG8_STAGE(PG8_SB(1, 0), b3, voffB);
            PG8_BAR; PG8_WAIT_L(0); PG8_MMA(0, 1, At, B1); PG8_BAR;
            PG8_LDA(At, 1, 1); PG8_STAGE(PG8_SA(1, 0), a3, voffA);
            PG8_BAR; PG8_WAIT_L(0); PG8_MMA(1, 0, At, B0); PG8_BAR; PG8_SCHED;
            PG8_STAGE(PG8_SB(1, 1), b3 + hstep, voffB);
            PG8_WAIT_V(6); PG8_BAR; PG8_MMA(1, 1, At, B1); PG8_BAR;
            }
        }
        if constexpr (ALIGN_EPI) { if (wr == 0) PG8_BAR; }
        if constexpr (!Epi::AFTER_DRAIN) { E(acc, cur, wr, wc, fr, fq); S.done(cur); }
        if (!has_next) break;
#pragma unroll
        for (int a = 0; a < 2; ++a)
#pragma unroll
            for (int b = 0; b < 2; ++b)
#pragma unroll
                for (int m = 0; m < 4; ++m)
#pragma unroll
                    for (int n = 0; n < 2; ++n) acc[a][b][m][n] = (f32x4){0.f, 0.f, 0.f, 0.f};
        cur = nxt; cA = nA; cB = nB; ++ui;
        if constexpr (ALIGN_EPI) { if (wr == 1) PG8_BAR; }
    }
    PG8_WAIT_V(0);
    if constexpr (!ALIGN_EPI) { if (wr == 0) PG8_BAR; }
    PG8_BAR;
    if constexpr (Epi::AFTER_DRAIN) { E.fused(acc, cur, wr, wc, fr, fq, lds, wid, lane); S.done(cur); }
#undef PG8_SA
#undef PG8_SB
#undef PG8_STAGE
#undef PG8_LDA
#undef PG8_LDB
#undef PG8_MMA
#undef PG8_WAIT_V
#undef PG8_WAIT_L
#undef PG8_BAR
#undef PG8_SCHED
}
}

#define LAS __attribute__((address_space(3)))
#define XB_TMO      128
#define XB_XCNT(j)  (256  + 64 * (j))
#define XB_XSUB(j)  (1280 + 64 * (j))
#define XB_XGEN(j)  (2304 + 64 * (j))
#define XB_TOP      3328
#define XB_TOPGEN   3392
#define XCD_BAR_WORDS 3456
#define XB_SPIN_CAP (1u << 23)

__device__ __forceinline__ unsigned xb_ld(unsigned* p)              { return __hip_atomic_load(p, __ATOMIC_RELAXED, __HIP_MEMORY_SCOPE_AGENT); }
__device__ __forceinline__ unsigned xb_add(unsigned* p, unsigned v) { return __hip_atomic_fetch_add(p, v, __ATOMIC_RELAXED, __HIP_MEMORY_SCOPE_AGENT); }
__device__ __forceinline__ unsigned xb_xcc_id() { return (unsigned)__builtin_amdgcn_s_getreg((3 << 11) | 20) & 0xFu; }
#define XB_SPIN(cond, bar) do { unsigned _sp = 0; while (cond) { __builtin_amdgcn_s_sleep(1); \
    if ((++_sp & 255u) == 0u) { if (xb_ld(&(bar)[XB_TMO])) break; if (_sp > XB_SPIN_CAP) { atomicAdd(&(bar)[XB_TMO], 1u); break; } } } } while (0)

struct XcdBarrier {
    unsigned* bar; unsigned x;
    volatile LAS unsigned* st;
};

__device__ __forceinline__ XcdBarrier xcd_barrier_post(unsigned* bar, volatile LAS unsigned* st) {
    XcdBarrier b; b.bar = bar; b.x = xb_xcc_id(); b.st = st;
    if (threadIdx.x == 0) (void)xb_add(&bar[XB_XCNT(b.x)], 1u);
    return b;
}
__device__ __forceinline__ void xcd_barrier_complete(unsigned* bar, unsigned x, unsigned& nloc, unsigned& nx) {
    const unsigned G = gridDim.x * gridDim.y * gridDim.z;
    unsigned sum, cnt, mine, sp = 0u;
    for (;;) {
        sum = 0u; cnt = 0u; mine = 0u;
#pragma unroll
        for (unsigned j = 0; j < 16; ++j) { const unsigned c = xb_ld(&bar[XB_XCNT(j)]); sum += c; cnt += (c > 0u) ? 1u : 0u; mine = (j == x) ? c : mine; }
        if (sum == G) break;
        __builtin_amdgcn_s_sleep(1);
        if ((++sp & 255u) == 0u) { if (xb_ld(&bar[XB_TMO])) break; if (sp > XB_SPIN_CAP) { atomicAdd(&bar[XB_TMO], 1u); break; } }
    }
    nloc = mine > 0u ? mine : 1u; nx = cnt > 0u ? cnt : 1u;
}

__device__ __forceinline__ void xcd_barrier(const XcdBarrier& b) {
    asm volatile("s_waitcnt vmcnt(0)" ::: "memory");
    __syncthreads();
    if (threadIdx.x == 0) {
        unsigned* bar = b.bar;
        __builtin_amdgcn_s_waitcnt(0);
        unsigned nloc = b.st[0], nx = b.st[1];
        if (nloc == 0u) { xcd_barrier_complete(bar, b.x, nloc, nx); b.st[0] = nloc; b.st[1] = nx; }
        const unsigned old = xb_add(&bar[XB_XSUB(b.x)], 1u);
        const unsigned gen = old / nloc;
        if (old + 1u == (gen + 1u) * nloc) {
            __builtin_amdgcn_fence(__ATOMIC_RELEASE, "agent");
            asm volatile("s_waitcnt vmcnt(0)" ::: "memory");
            const unsigned og = xb_add(&bar[XB_TOP], 1u);
            const unsigned tg = og / nx;
            if (og + 1u == (tg + 1u) * nx) xb_add(&bar[XB_TOPGEN], 1u);
            else XB_SPIN(xb_ld(&bar[XB_TOPGEN]) == tg, bar);
            __builtin_amdgcn_fence(__ATOMIC_ACQUIRE, "agent");
            xb_add(&bar[XB_XGEN(b.x)], 1u);
            asm volatile("s_waitcnt vmcnt(0)" ::: "memory");
        } else {
            XB_SPIN(xb_ld(&bar[XB_XGEN(b.x)]) == gen, bar);
            __builtin_amdgcn_fence(__ATOMIC_ACQUIRE, "agent");
            asm volatile("s_waitcnt vmcnt(0)" ::: "memory");
        }
    }
    __syncthreads();
}

using pg8::bf16_t; using pg8::bf16x8; using pg8::f32x4; using pg8::u32x4; using pg8::u32x2; using pg8::cvt_pk_bf16;

constexpr int NBATCH = 8, SEQ = 2048, CTXL = 256;
constexpr int ML = NBATCH * SEQ, MC = NBATCH * CTXL, MT = ML + MC;
constexpr int DFF = 2816, DRNN = 1408, MODLD = 9216;
constexpr int LDS_BYTES = 131072 + 64;
constexpr float LOG2E = 1.4426950408889634f;

struct Params {
    const float *x, *c, *ctx, *c_ctx, *mod_w, *mod_b, *ln_g, *ln_b, *ffn_w_in, *ffn_w_out, *na_w_qkv, *na_w_o, *na_rpb,
                *lru_w_in, *lru_conv_w, *lru_conv_b, *lru_wg, *lru_bg, *lru_lam, *lru_w_out, *sc_w_in, *sc_conv_w, *sc_w_out;
    float* out;
    unsigned char* ws;
};

constexpr size_t SZ_FFN_IN = (size_t)5632 * 1024 * 2, SZ_FFN_OUT = (size_t)1024 * 2816 * 2;
constexpr size_t OFF_W_FFN_IN = 0;
constexpr size_t OFF_W_FFN_OUT = OFF_W_FFN_IN + 8 * SZ_FFN_IN;
constexpr size_t OFF_W_QK = OFF_W_FFN_OUT + 8 * SZ_FFN_OUT;
constexpr size_t OFF_W_V = OFF_W_QK + 2 * (size_t)2048 * 1024 * 2;
constexpr size_t OFF_W_O = OFF_W_V + 2 * (size_t)1024 * 1024 * 2;
constexpr size_t OFF_W_LIN = OFF_W_O + 2 * (size_t)1024 * 1024 * 2;
constexpr size_t OFF_W_LOUT = OFF_W_LIN + (size_t)2816 * 1024 * 2;
constexpr size_t OFF_W_SIN = OFF_W_LOUT + (size_t)1024 * 1408 * 2;
constexpr size_t OFF_W_SOUT = OFF_W_SIN + (size_t)3072 * 1024 * 2;
constexpr size_t OFF_W_G = OFF_W_SOUT + (size_t)1024 * 1024 * 2;
constexpr size_t OFF_MOD = OFF_W_G + (size_t)16 * 384 * 96 * 2;
constexpr size_t OFF_XZ = OFF_MOD + (size_t)4 * 9 * 9216 * 4;
constexpr size_t OFF_H = OFF_XZ + (size_t)MT * 1024 * 4;
constexpr size_t OFF_ACT = OFF_H + (size_t)MT * 1024 * 2;
constexpr size_t OFF_UCONV = OFF_ACT + (size_t)MT * 3072 * 2;
constexpr size_t OFF_LAB = OFF_UCONV + (size_t)MT * 1408 * 2 + 256;
constexpr size_t OFF_BAR = OFF_LAB + 4 * (size_t)MT * 1408 * 2 + 256;
constexpr size_t WS_END = OFF_BAR + (size_t)XCD_BAR_WORDS * 4 + 256;

__device__ __forceinline__ float bf2f(unsigned v) { return __uint_as_float(v << 16); }
__device__ __forceinline__ float bflo(unsigned v) { return __uint_as_float(v << 16); }
__device__ __forceinline__ float bfhi(unsigned v) { return __uint_as_float(v & 0xffff0000u); }
__device__ __forceinline__ bf16_t f2bf(float v) { return (bf16_t)(cvt_pk_bf16(v, 0.f) & 0xffffu); }
__device__ __forceinline__ float wave_sum(float v) {
#pragma unroll
    for (int o = 1; o < 64; o <<= 1) v += __shfl_xor(v, o);
    return v;
}
__device__ __forceinline__ f32x4 mfma16(bf16x8 a, bf16x8 b, f32x4 c) { return __builtin_amdgcn_mfma_f32_16x16x32_bf16(a, b, c, 0, 0, 0); }

__device__ __forceinline__ void conv_tile(const float* src, int ld, int col0, int K, int N, int base, int Hh, bf16_t* dst, int tile, LAS float* fl, int tid) {
    const int ntn = N >> 7, kb = tile / ntn, nb = tile - kb * ntn, k0 = kb * 64, n0 = nb * 128;
    int sc;
    if (n0 < base) sc = n0; else { const int q = n0 - base, pn = q >> 8, bj = (q >> 7) & 1; sc = base + bj * Hh + 128 * pn; }
    sc += col0;
    const int nn2 = (tid & 63) * 2;
#pragma unroll
    for (int i = 0; i < 8; ++i) { const int kk = (tid >> 6) + 8 * i; const float2 v = *(const float2*)(src + (size_t)(k0 + kk) * ld + sc + nn2); fl[kk * 129 + nn2] = v.x; fl[kk * 129 + nn2 + 1] = v.y; }
    __syncthreads();
    const int kk2 = 2 * (tid & 31);
#pragma unroll
    for (int i = 0; i < 8; ++i) { const int nn = (tid >> 5) + 16 * i; const unsigned w = cvt_pk_bf16(fl[kk2 * 129 + nn], fl[(kk2 + 1) * 129 + nn]); *(unsigned*)(dst + (size_t)(n0 + nn) * K + k0 + kk2) = w; }
    __syncthreads();
}

__device__ __forceinline__ void ln_phase(float* XZ, bf16_t* H, float* out, const float* g, const float* b, const float* modn, bool is_final, int Mrows, int gw, int ngw, int lane) {
    for (int row = gw; row < Mrows; row += ngw) {
        const f32x4* zr = (const f32x4*)(XZ + (size_t)row * 1024) + lane;
        f32x4 v[4]; float s = 0.f;
#pragma unroll
        for (int j = 0; j < 4; ++j) { v[j] = zr[64 * j]; s += (v[j][0] + v[j][1]) + (v[j][2] + v[j][3]); }
        const float mean = wave_sum(s) * (1.0f / 1024.0f); float s2 = 0.f;
#pragma unroll
        for (int j = 0; j < 4; ++j) { v[j] = v[j] - mean; s2 += (v[j][0] * v[j][0] + v[j][1] * v[j][1]) + (v[j][2] * v[j][2] + v[j][3] * v[j][3]); }
        const float rstd = 1.0f / sqrtf(wave_sum(s2) * (1.0f / 1024.0f) + 1e-5f);
        const int mi = row < ML ? (row >> 11) : 8;
#pragma unroll
        for (int j = 0; j < 4; ++j) {
            const int col = 256 * j + 4 * lane;
            const f32x4 gg = *(const f32x4*)(g + col), bb = *(const f32x4*)(b + col);
            const f32x4 xv = v[j] * rstd * gg + bb;
            if (is_final) { *(f32x4*)(out + (size_t)row * 1024 + col) = xv; }
            else {
                *(f32x4*)(XZ + (size_t)row * 1024 + col) = xv;
                const f32x4 sh = *(const f32x4*)(modn + (size_t)mi * MODLD + col), sc = *(const f32x4*)(modn + (size_t)mi * MODLD + 1024 + col);
                const f32x4 hv = xv * (sc + 1.0f) + sh;
                u32x2 w; w.x = cvt_pk_bf16(hv[0], hv[1]); w.y = cvt_pk_bf16(hv[2], hv[3]);
                *(u32x2*)(H + (size_t)row * 1024 + col) = w;
            }
        }
    }
}

__device__ __forceinline__ void attn_phase(const bf16_t* QK, const bf16_t* VT, bf16_t* O, const float* rpb, bool need_ctx, LAS float* btab, int gw, int ngw, int lane) {
    const int fr = lane & 15, fq = lane >> 4;
    const int nunits = 4096 + (need_ctx ? 512 : 0);
    const float SC2 = 0.125f * LOG2E;
    for (int u = gw; u < nunits; u += ngw) {
        int b, h, r, r0, tq0, nloc;
        if (u < 4096) { r = u & 31; h = (u >> 5) & 15; b = u >> 9; r0 = min(max(r - 4, 0), 24); tq0 = b * SEQ + r * 64; nloc = 16; }
        else { const int v = u - 4096; const int qc4 = v & 3; h = (v >> 2) & 15; b = v >> 6; r = 0; r0 = 0; tq0 = ML + b * CTXL + qc4 * 64; nloc = 0; }
        const int tk0 = b * SEQ + r0 * 64, tc0 = ML + b * CTXL;
        asm volatile("s_waitcnt lgkmcnt(0)" ::: "memory");
        for (int i = lane; i < 465; i += 64) btab[i] = rpb[h * 465 + i] * LOG2E;
        asm volatile("s_waitcnt lgkmcnt(0)" ::: "memory");
        bf16x8 bq[4][2];
#pragma unroll
        for (int qt = 0; qt < 4; ++qt)
#pragma unroll
            for (int ks = 0; ks < 2; ++ks) bq[qt][ks] = *(const bf16x8*)(QK + (size_t)(tq0 + 16 * qt + fr) * 2048 + h * 64 + 32 * ks + 8 * fq);
        f32x4 oacc[4][4];
#pragma unroll
        for (int dt = 0; dt < 4; ++dt)
#pragma unroll
            for (int qt = 0; qt < 4; ++qt) oacc[dt][qt] = (f32x4){0.f, 0.f, 0.f, 0.f};
        float mrun[4], lsum[4];
#pragma unroll
        for (int qt = 0; qt < 4; ++qt) { mrun[qt] = -1e29f; lsum[qt] = 0.f; }
        const int nsteps = nloc + 8;
        for (int s = 0; s < nsteps; ++s) {
            const bool loc = s < nloc;
            const int kt = loc ? tk0 + 32 * s : tc0 + 32 * (s - nloc);
            bf16x8 ak[2][2];
#pragma unroll
            for (int kt2 = 0; kt2 < 2; ++kt2)
#pragma unroll
                for (int ks = 0; ks < 2; ++ks) ak[kt2][ks] = *(const bf16x8*)(QK + (size_t)(kt + 16 * kt2 + fr) * 2048 + 1024 + h * 64 + 32 * ks + 8 * fq);
            bf16x8 av[4];
#pragma unroll
            for (int dt = 0; dt < 4; ++dt) { const bf16_t* vp = VT + (size_t)(h * 64 + 16 * dt + fr) * MT + kt + 4 * fq;
                const u32x2 lo = *(const u32x2*)vp, hi = *(const u32x2*)(vp + 16); u32x4 t4; t4.x = lo.x; t4.y = lo.y; t4.z = hi.x; t4.w = hi.y; av[dt] = __builtin_bit_cast(bf16x8, t4); }
            f32x4 sacc[2][4];
#pragma unroll
            for (int kt2 = 0; kt2 < 2; ++kt2)
#pragma unroll
                for (int qt = 0; qt < 4; ++qt) { f32x4 a = (f32x4){0.f, 0.f, 0.f, 0.f}; a = mfma16(ak[kt2][0], bq[qt][0], a); a = mfma16(ak[kt2][1], bq[qt][1], a); sacc[kt2][qt] = a; }
            if (loc) {
                const int jj = s >> 1, drow = r0 + jj - r + 7, kcb = (32 * s) & 63;
#pragma unroll
                for (int qt = 0; qt < 4; ++qt) {
                    const int qc = 16 * qt + fr, cs = min(max(qc - 8, 0), 48);
#pragma unroll
                    for (int kt2 = 0; kt2 < 2; ++kt2)
#pragma unroll
                        for (int j = 0; j < 4; ++j) { const int kc = kcb + 16 * kt2 + 4 * fq + j; const bool in = (kc >= cs) && (kc < cs + 16);
                            const int dcol = min(max(kc - qc + 15, 0), 30);
                            const float bias = btab[drow * 31 + dcol];
                            sacc[kt2][qt][j] = in ? (sacc[kt2][qt][j] * SC2 + bias) : -1e30f; }
                }
            } else {
#pragma unroll
                for (int qt = 0; qt < 4; ++qt)
#pragma unroll
                    for (int kt2 = 0; kt2 < 2; ++kt2) sacc[kt2][qt] = sacc[kt2][qt] * SC2;
            }
            bf16x8 bp[4];
#pragma unroll
            for (int qt = 0; qt < 4; ++qt) {
                float tm = fmaxf(fmaxf(fmaxf(sacc[0][qt][0], sacc[0][qt][1]), fmaxf(sacc[0][qt][2], sacc[0][qt][3])), fmaxf(fmaxf(sacc[1][qt][0], sacc[1][qt][1]), fmaxf(sacc[1][qt][2], sacc[1][qt][3])));
                tm = fmaxf(tm, __shfl_xor(tm, 16)); tm = fmaxf(tm, __shfl_xor(tm, 32));
                const float mnew = fmaxf(mrun[qt], tm), alpha = __builtin_amdgcn_exp2f(mrun[qt] - mnew);
                mrun[qt] = mnew;
                float pv[8], ps = 0.f;
#pragma unroll
                for (int kt2 = 0; kt2 < 2; ++kt2)
#pragma unroll
                    for (int j = 0; j < 4; ++j) { pv[kt2 * 4 + j] = __builtin_amdgcn_exp2f(sacc[kt2][qt][j] - mnew); ps += pv[kt2 * 4 + j]; }
                lsum[qt] = lsum[qt] * alpha + ps;
#pragma unroll
                for (int dt = 0; dt < 4; ++dt) oacc[dt][qt] = oacc[dt][qt] * alpha;
                u32x4 t4; t4.x = cvt_pk_bf16(pv[0], pv[1]); t4.y = cvt_pk_bf16(pv[2], pv[3]); t4.z = cvt_pk_bf16(pv[4], pv[5]); t4.w = cvt_pk_bf16(pv[6], pv[7]);
                bp[qt] = __builtin_bit_cast(bf16x8, t4);
            }
#pragma unroll
            for (int dt = 0; dt < 4; ++dt)
#pragma unroll
                for (int qt = 0; qt < 4; ++qt) oacc[dt][qt] = mfma16(av[dt], bp[qt], oacc[dt][qt]);
        }
#pragma unroll
        for (int qt = 0; qt < 4; ++qt) {
            float l = lsum[qt]; l += __shfl_xor(l, 16); l += __shfl_xor(l, 32);
            const float inv = 1.0f / l;
#pragma unroll
            for (int dt = 0; dt < 4; ++dt) { const f32x4 v = oacc[dt][qt] * inv; u32x2 w; w.x = cvt_pk_bf16(v[0], v[1]); w.y = cvt_pk_bf16(v[2], v[3]);
                *(u32x2*)(O + (size_t)(tq0 + 16 * qt + fr) * 1024 + h * 64 + 16 * dt + 4 * fq) = w; }
        }
    }
}

__device__ __forceinline__ void lru_gates_phase(const bf16_t* UC, const bf16_t* WG, const float* bgates, const float* lam, bf16_t* LAB, LAS unsigned char* lds, int c, int G, int tid) {
    const int wid = tid >> 6, lane = tid & 63, fr = lane & 15, fq = lane >> 4;
    LAS float* tab_sp = (LAS float*)(lds + 79872);
    LAS float* tab_b = (LAS float*)(lds + 79872 + 768);
    for (int u = c; u < 256; u += G) {
        const int nb = u & 15, chunk = u >> 4;
        for (int i = tid; i < 4608; i += 512) { const int row = i / 12, pc = i - row * 12; const u32x4 v = *(const u32x4*)(WG + ((size_t)nb * 384 + row) * 96 + pc * 8); *(LAS u32x4*)(lds + row * 208 + pc * 16) = v; }
        if (tid < 192) { const int d = tid / 96, jl = tid - d * 96; float v = 0.f; if (jl < 88) { const float lm = lam[d * DRNN + nb * 88 + jl]; v = 8.0f * log1pf(__expf(-lm)); } tab_sp[tid] = v; }
        else if (tid < 576) { const int t2 = tid - 192, q = t2 / 96, jl = t2 - q * 96; tab_b[t2] = (jl < 88) ? bgates[q * DRNN + nb * 88 + jl] : 0.f; }
        __syncthreads();
        for (int it = 0; it < 9; ++it) {
            const int row0 = chunk * 1152 + (it * 8 + wid) * 16;
            bf16x8 bu[3];
#pragma unroll
            for (int ks = 0; ks < 3; ++ks) bu[ks] = *(const bf16x8*)(UC + (size_t)(row0 + fr) * DRNN + nb * 88 + ks * 32 + fq * 8);
            f32x4 acc[4][6];
#pragma unroll
            for (int q = 0; q < 4; ++q)
#pragma unroll
                for (int jt = 0; jt < 6; ++jt) { f32x4 a = (f32x4){0.f, 0.f, 0.f, 0.f};
#pragma unroll
                    for (int ks = 0; ks < 3; ++ks) { const bf16x8 aw = *(const LAS bf16x8*)(lds + (q * 96 + 16 * jt + fr) * 208 + (ks * 32 + fq * 8) * 2); a = mfma16(aw, bu[ks], a); }
                    acc[q][jt] = a; }
#pragma unroll
            for (int jt = 0; jt < 6; ++jt) {
                if (jt < 5 || fq < 2) {
                    const int cl = 16 * jt + 4 * fq; const size_t off = (size_t)(row0 + fr) * DRNN + nb * 88 + cl;
                    const u32x2 ur = *(const u32x2*)(UC + off);
                    float uu[4]; uu[0] = bflo(ur.x); uu[1] = bfhi(ur.x); uu[2] = bflo(ur.y); uu[3] = bfhi(ur.y);
#pragma unroll
                    for (int d = 0; d < 2; ++d) {
                        float la[4], bb[4];
#pragma unroll
                        for (int j = 0; j < 4; ++j) {
                            const float gr = acc[2 * d][jt][j] + tab_b[(2 * d) * 96 + cl + j], gi = acc[2 * d + 1][jt][j] + tab_b[(2 * d + 1) * 96 + cl + j];
                            const float rr = pg8::fast_sigmoid(gr), ii = pg8::fast_sigmoid(gi);
                            const float l = -rr * tab_sp[d * 96 + cl + j];
                            const float a2 = __expf(2.0f * l);
                            la[j] = l; bb[j] = sqrtf(fmaxf(1.0f - a2, 0.f)) * ii * uu[j];
                        }
                        u32x2 w0, w1; w0.x = cvt_pk_bf16(la[0], la[1]); w0.y = cvt_pk_bf16(la[2], la[3]); w1.x = cvt_pk_bf16(bb[0], bb[1]); w1.y = cvt_pk_bf16(bb[2], bb[3]);
                        *(u32x2*)(LAB + (size_t)(2 * d) * MT * DRNN + off) = w0;
                        *(u32x2*)(LAB + (size_t)(2 * d + 1) * MT * DRNN + off) = w1;
                    }
                }
            }
        }
        __syncthreads();
    }
}

__device__ __forceinline__ int scan_row(int b, int p, bool rev) {
    if (!rev) return p < CTXL ? ML + b * CTXL + p : b * SEQ + (p - CTXL);
    return p < CTXL ? ML + b * CTXL + (CTXL - 1 - p) : b * SEQ + (SEQ - 1 - (p - CTXL));
}
template <bool P2, bool REV>
__device__ __forceinline__ void scan_chunk(const bf16_t* LA, const bf16_t* BB, const bf16_t* GATE, bf16_t* YF, bf16_t* YIN, int b, int ch, int p0, float& h, float& sl) {
    constexpr int NBT = 8;
    float laA[NBT], bbA[NBT], ggA[NBT], yfA[NBT], laB[NBT], bbB[NBT], ggB[NBT], yfB[NBT];
#define SC_LOAD(la, bb, gg, yf, t0) _Pragma("unroll") for (int i = 0; i < NBT; ++i) { const size_t o = (size_t)scan_row(b, p0 + (t0) + i, REV) * DRNN + ch; \
        la[i] = bf2f(LA[o]); bb[i] = bf2f(BB[o]); if (P2 && REV) { gg[i] = bf2f(GATE[o]); yf[i] = bf2f(YF[o]); } }
#define SC_COMP(la, bb, gg, yf, t0) _Pragma("unroll") for (int i = 0; i < NBT; ++i) { h = __expf(la[i]) * h + bb[i]; if (!P2) sl += la[i]; \
        if (P2) { const size_t o = (size_t)scan_row(b, p0 + (t0) + i, REV) * DRNN + ch; if (REV) YIN[o] = f2bf(gg[i] * (yf[i] + h)); else YF[o] = f2bf(h); } }
    SC_LOAD(laA, bbA, ggA, yfA, 0);
    for (int t0 = 0; t0 < 288; t0 += 2 * NBT) {
        SC_LOAD(laB, bbB, ggB, yfB, t0 + NBT);
        SC_COMP(laA, bbA, ggA, yfA, t0);
        if (t0 + 2 * NBT < 288) { SC_LOAD(laA, bbA, ggA, yfA, t0 + 2 * NBT); }
        SC_COMP(laB, bbB, ggB, yfB, t0 + NBT);
    }
#undef SC_LOAD
#undef SC_COMP
}
enum { OP_FFN_IN = 0, OP_FFN_OUT, OP_LN_FFN, OP_LN_MIX, OP_QK, OP_VT, OP_ATT, OP_NA_O, OP_LIN, OP_CONV4, OP_GATES, OP_SCAN, OP_LOUT, OP_SIN, OP_CONV3, OP_SOUT };
struct Op { int op, l, s, sync; };
__constant__ Op PROG[] = {
    {OP_FFN_IN, 0, 0, 1}, {OP_FFN_OUT, 0, 0, 1}, {OP_LN_FFN, 0, 0, 1},
    {OP_QK, 0, 0, 0}, {OP_VT, 0, 0, 1}, {OP_ATT, 0, 0, 1}, {OP_NA_O, 0, 0, 1}, {OP_LN_MIX, 0, 0, 1},
    {OP_FFN_IN, 0, 1, 1}, {OP_FFN_OUT, 0, 1, 1}, {OP_LN_FFN, 0, 1, 1},
    {OP_FFN_IN, 1, 0, 1}, {OP_FFN_OUT, 1, 0, 1}, {OP_LN_FFN, 1, 0, 1},
    {OP_LIN, 1, 0, 1}, {OP_CONV4, 1, 0, 1}, {OP_GATES, 1, 0, 1}, {OP_SCAN, 1, 0, 1}, {OP_LOUT, 1, 0, 1}, {OP_LN_MIX, 1, 0, 1},
    {OP_FFN_IN, 1, 1, 1}, {OP_FFN_OUT, 1, 1, 1}, {OP_LN_FFN, 1, 1, 1},
    {OP_FFN_IN, 2, 0, 1}, {OP_FFN_OUT, 2, 0, 1}, {OP_LN_FFN, 2, 0, 1},
    {OP_SIN, 2, 0, 1}, {OP_CONV3, 2, 0, 1}, {OP_SOUT, 2, 0, 1}, {OP_LN_MIX, 2, 0, 1},
    {OP_FFN_IN, 2, 1, 1}, {OP_FFN_OUT, 2, 1, 1}, {OP_LN_FFN, 2, 1, 1},
    {OP_FFN_IN, 3, 0, 1}, {OP_FFN_OUT, 3, 0, 1}, {OP_LN_FFN, 3, 0, 1},
    {OP_QK, 3, 0, 0}, {OP_VT, 3, 0, 1}, {OP_ATT, 3, 0, 1}, {OP_NA_O, 3, 0, 1}, {OP_LN_MIX, 3, 0, 1},
    {OP_FFN_IN, 3, 1, 1}, {OP_FFN_OUT, 3, 1, 1}, {OP_LN_FFN, 3, 1, 0},
};
constexpr int NPROG = sizeof(PROG) / sizeof(Op);

__global__ void __launch_bounds__(512, 2) fwd_kernel(Params p) {
    extern __shared__ __attribute__((aligned(16))) unsigned char smem[];
    cg::grid_group grid = cg::this_grid();
    LAS unsigned char* lds = (LAS unsigned char*)smem;
    const int G = gridDim.x, c = blockIdx.x;
    unsigned char* ws = p.ws;
    unsigned* bar = (unsigned*)(ws + OFF_BAR);
    volatile LAS unsigned* xst = (volatile LAS unsigned*)(lds + 131072);
    if (c == 0) for (int i = threadIdx.x; i < XCD_BAR_WORDS; i += 512) __hip_atomic_store(&bar[i], 0u, __ATOMIC_RELAXED, __HIP_MEMORY_SCOPE_AGENT);
    if (threadIdx.x == 0) { xst[0] = 0u; xst[1] = 0u; }
    __syncthreads();
    {
        const int tid = threadIdx.x;
        const int gtid = c * 512 + tid, ngt = G * 512;
        bf16_t* W_G = (bf16_t*)(ws + OFF_W_G); float* MOD = (float*)(ws + OFF_MOD);
        LAS float* fl = (LAS float*)lds;
        constexpr int NT = 8 * 704 + 8 * 352 + 2 * 256 + 2 * 128 + 2 * 128 + 352 + 176 + 384 + 128;
        for (int u = c; u < NT; u += G) {
            int r = u; const float* src; size_t doff; int ld, col0 = 0, K = 1024, N, base = 1 << 30, Hh = 0;
            if (r < 8 * 704) { const int j = r / 704; r -= j * 704; src = p.ffn_w_in + (size_t)j * 1024 * 5632; doff = OFF_W_FFN_IN + (size_t)j * SZ_FFN_IN; ld = 5632; N = 5632; base = 0; Hh = 2816; }
            else if ((r -= 8 * 704) < 8 * 352) { const int j = r / 352; r -= j * 352; src = p.ffn_w_out + (size_t)j * 2816 * 1024; doff = OFF_W_FFN_OUT + (size_t)j * SZ_FFN_OUT; ld = 1024; N = 1024; K = 2816; }
            else if ((r -= 8 * 352) < 2 * 256) { const int j = r / 256; r -= j * 256; src = p.na_w_qkv + (size_t)j * 1024 * 3072; doff = OFF_W_QK + (size_t)j * 2048 * 1024 * 2; ld = 3072; N = 2048; }
            else if ((r -= 2 * 256) < 2 * 128) { const int j = r / 128; r -= j * 128; src = p.na_w_qkv + (size_t)j * 1024 * 3072; doff = OFF_W_V + (size_t)j * 1024 * 1024 * 2; ld = 3072; N = 1024; col0 = 2048; }
            else if ((r -= 2 * 128) < 2 * 128) { const int j = r / 128; r -= j * 128; src = p.na_w_o + (size_t)j * 1024 * 1024; doff = OFF_W_O + (size_t)j * 1024 * 1024 * 2; ld = 1024; N = 1024; }
            else if ((r -= 2 * 128) < 352) { src = p.lru_w_in; doff = OFF_W_LIN; ld = 2816; N = 2816; }
            else if ((r -= 352) < 176) { src = p.lru_w_out; doff = OFF_W_LOUT; ld = 1024; N = 1024; K = 1408; }
            else if ((r -= 176) < 384) { src = p.sc_w_in; doff = OFF_W_SIN; ld = 3072; N = 3072; base = 1024; Hh = 1024; }
            else { r -= 384; src = p.sc_w_out; doff = OFF_W_SOUT; ld = 1024; N = 1024; }
            conv_tile(src, ld, col0, K, N, base, Hh, (bf16_t*)(ws + doff), r, fl, tid);
        }
        for (int i = gtid; i < 16 * 384 * 96; i += ngt) {
            const int k = i % 96, rj = (i / 96) % 384, nb = i / (96 * 384), q = rj / 96, j = rj - q * 96;
            float v = 0.f; if (j < 88 && k < 88) v = p.lru_wg[(((size_t)q * 16 + nb) * 88 + k) * 88 + j];
            W_G[i] = f2bf(v);
        }
        LAS float* scnd = (LAS float*)lds;
        LAS float* red = (LAS float*)(lds + 36864);
        __syncthreads();
        for (int i = tid; i < 9216; i += 512) { const float v = (i < 8192) ? p.c[i] : p.c_ctx[i - 8192]; scnd[i] = pg8::silu_f(v); }
        __syncthreads();
        for (int u = c; u < 576; u += G) {
            const int l = u / 144, n0 = (u - l * 144) * 64, col = tid & 63, kg = tid >> 6;
            const float* w = p.mod_w + (size_t)l * 1024 * MODLD + n0 + col;
            float a9[9];
#pragma unroll
            for (int i = 0; i < 9; ++i) a9[i] = 0.f;
#pragma unroll 8
            for (int k = kg * 128; k < kg * 128 + 128; ++k) { const float wv = w[(size_t)k * MODLD];
#pragma unroll
                for (int i = 0; i < 9; ++i) a9[i] += scnd[i * 1024 + k] * wv; }
#pragma unroll
            for (int i = 0; i < 9; ++i) red[(kg * 9 + i) * 64 + col] = a9[i];
            __syncthreads();
            for (int idx = tid; idx < 576; idx += 512) { const int i = idx >> 6, cc = idx & 63; float s = p.mod_b[l * MODLD + n0 + cc];
#pragma unroll
                for (int k2 = 0; k2 < 8; ++k2) s += red[(k2 * 9 + i) * 64 + cc];
                MOD[((size_t)l * 9 + i) * MODLD + n0 + cc] = s; }
            __syncthreads();
        }
    }
    grid.sync();
    const XcdBarrier xb = xcd_barrier_post(bar, xst);
    {
        const int tid = threadIdx.x, wid = tid >> 6, lane = tid & 63;
        float* MOD = (float*)(ws + OFF_MOD); float* XZ = (float*)(ws + OFF_XZ); bf16_t* H = (bf16_t*)(ws + OFF_H);
        for (int row = c * 8 + wid; row < MT; row += G * 8) {
            const float* srow = row < ML ? p.x + (size_t)row * 1024 : p.ctx + (size_t)(row - ML) * 1024;
            const int mi = row < ML ? (row >> 11) : 8;
#pragma unroll
            for (int j = 0; j < 4; ++j) { const int col = 256 * j + 4 * lane; const f32x4 v = *(const f32x4*)(srow + col);
                *(f32x4*)(XZ + (size_t)row * 1024 + col) = v;
                const f32x4 sh = *(const f32x4*)(MOD + (size_t)mi * MODLD + col), sc = *(const f32x4*)(MOD + (size_t)mi * MODLD + 1024 + col);
                const f32x4 hv = v * (sc + 1.0f) + sh; u32x2 w; w.x = cvt_pk_bf16(hv[0], hv[1]); w.y = cvt_pk_bf16(hv[2], hv[3]);
                *(u32x2*)(H + (size_t)row * 1024 + col) = w; }
        }
    }
    xcd_barrier(xb);

    for (int pc = 0; pc < NPROG; ++pc) {
        const int op = PROG[pc].op, l = PROG[pc].l, s = PROG[pc].s, dosync = PROG[pc].sync;
        int tidv = threadIdx.x; asm volatile("" : "+v"(tidv));
        const int tid = tidv, wid = tid >> 6, lane = tid & 63;
        const int gw = c * 8 + wid, ngw = G * 8, gtid = c * 512 + tid, ngt = G * 512;
        float* MOD = (float*)(ws + OFF_MOD); float* XZ = (float*)(ws + OFF_XZ);
        bf16_t* H = (bf16_t*)(ws + OFF_H); bf16_t* ACT = (bf16_t*)(ws + OFF_ACT); bf16_t* UCONV = (bf16_t*)(ws + OFF_UCONV); bf16_t* LAB = (bf16_t*)(ws + OFF_LAB);
        const float* MODL = MOD + (size_t)l * 9 * MODLD;
        const int Mff = (l == 3 && s == 1) ? ML : MT;
        const int Mmix = (l == 3) ? ML : MT;
        const int idx = l / 3;
        switch (op) {
        case OP_FFN_IN: case OP_SIN: {
            pg8::Gemm g; pg8::EpiPair E;
            if (op == OP_FFN_IN) { g = pg8::Gemm{H, (const bf16_t*)(ws + OFF_W_FFN_IN + (size_t)(l * 2 + s) * SZ_FFN_IN), Mff, 5632, 1024}; E = pg8::EpiPair{ACT, ACT, DFF, DFF, 0}; }
            else { g = pg8::Gemm{H, (const bf16_t*)(ws + OFF_W_SIN), MT, 3072, 1024}; E = pg8::EpiPair{ACT, ACT + (size_t)MT * 1024, 1024, 1024, 1}; }
            pg8::StaticOrder S; S.init(g.M, g.N, G, c);
            pg8::gemm_phase<pg8::EpiPair, pg8::StaticOrder, true, true>(lds, g, S, E);
        } break;
        case OP_QK: case OP_VT: case OP_LIN: {
            pg8::Gemm g; pg8::EpiSplit E; int cc = c;
            if (op == OP_QK) { g = pg8::Gemm{H, (const bf16_t*)(ws + OFF_W_QK + (size_t)idx * 2048 * 1024 * 2), MT, 2048, 1024}; E = pg8::EpiSplit{ACT, ACT, 1 << 30, 2048, 2048, 0}; }
            else if (op == OP_VT) { bf16_t* VT = ACT + (size_t)MT * 2048; g = pg8::Gemm{(const bf16_t*)(ws + OFF_W_V + (size_t)idx * 1024 * 1024 * 2), H, 1024, MT, 1024}; E = pg8::EpiSplit{VT, VT, 1 << 30, MT, MT, 0}; cc = (c + 192) % G; }
            else { g = pg8::Gemm{H, (const bf16_t*)(ws + OFF_W_LIN), MT, 2816, 1024}; E = pg8::EpiSplit{ACT, ACT + (size_t)MT * DRNN, DRNN, DRNN, DRNN, 1}; }
            pg8::StaticOrder S; S.init(g.M, g.N, G, cc);
            pg8::gemm_phase<pg8::EpiSplit, pg8::StaticOrder, true, true>(lds, g, S, E);
        } break;
        case OP_FFN_OUT: case OP_NA_O: case OP_LOUT: case OP_SOUT: {
            pg8::Gemm g; pg8::EpiRes E;
            if (op == OP_FFN_OUT) { g = pg8::Gemm{ACT, (const bf16_t*)(ws + OFF_W_FFN_OUT + (size_t)(l * 2 + s) * SZ_FFN_OUT), Mff, 1024, 2816}; E = pg8::EpiRes{XZ, MODL + (s == 0 ? 2 : 8) * 1024, 0.5f}; }
            else if (op == OP_NA_O) { g = pg8::Gemm{H, (const bf16_t*)(ws + OFF_W_O + (size_t)idx * 1024 * 1024 * 2), Mmix, 1024, 1024}; E = pg8::EpiRes{XZ, MODL + 5 * 1024, 1.0f}; }
            else if (op == OP_LOUT) { g = pg8::Gemm{UCONV, (const bf16_t*)(ws + OFF_W_LOUT), Mmix, 1024, DRNN}; E = pg8::EpiRes{XZ, MODL + 5 * 1024, 1.0f}; }
            else { g = pg8::Gemm{ACT + (size_t)2 * MT * 1024, (const bf16_t*)(ws + OFF_W_SOUT), Mmix, 1024, 1024}; E = pg8::EpiRes{XZ, MODL + 5 * 1024, 1.0f}; }
            pg8::StaticOrder S; S.init(g.M, g.N, G, c);
            pg8::gemm_phase<pg8::EpiRes, pg8::StaticOrder, true, true>(lds, g, S, E);
        } break;
        case OP_LN_FFN: {
            const bool fin = (l == 3 && s == 1);
            const int j3 = (s == 0) ? 0 : 2;
            const float* modn = fin ? MOD : ((s == 0) ? (MODL + 3 * 1024) : (MOD + (size_t)(l + 1) * 9 * MODLD));
            ln_phase(XZ, H, p.out, p.ln_g + (l * 3 + j3) * 1024, p.ln_b + (l * 3 + j3) * 1024, modn, fin, Mff, gw, ngw, lane);
        } break;
        case OP_LN_MIX: {
            ln_phase(XZ, H, p.out, p.ln_g + (l * 3 + 1) * 1024, p.ln_b + (l * 3 + 1) * 1024, MODL + 6 * 1024, false, Mmix, gw, ngw, lane);
        } break;
        case OP_ATT: {
            attn_phase(ACT, ACT + (size_t)MT * 2048, H, p.na_rpb + (size_t)idx * 16 * 465, l < 3, (LAS float*)lds + wid * 480, gw, ngw, lane);
        } break;
        case OP_CONV4: {
            const bf16_t* U = ACT + (size_t)MT * DRNN;
            for (int it = gtid; it < MT * 176; it += ngt) {
                const int row = it / 176, c0 = (it - row * 176) * 8;
                int sq, len; if (row < ML) { sq = row & 2047; len = SEQ; } else { sq = (row - ML) & 255; len = CTXL; }
                float a8[8];
                { const f32x4 b0 = *(const f32x4*)(p.lru_conv_b + c0), b1 = *(const f32x4*)(p.lru_conv_b + c0 + 4);
                  a8[0] = b0[0]; a8[1] = b0[1]; a8[2] = b0[2]; a8[3] = b0[3]; a8[4] = b1[0]; a8[5] = b1[1]; a8[6] = b1[2]; a8[7] = b1[3]; }
#pragma unroll
                for (int k = 0; k < 4; ++k) { const int t = sq + k - 2;
                    if (t >= 0 && t < len) { const u32x4 uv = *(const u32x4*)(U + (size_t)(row + k - 2) * DRNN + c0);
                        const f32x4 w0 = *(const f32x4*)(p.lru_conv_w + k * DRNN + c0), w1 = *(const f32x4*)(p.lru_conv_w + k * DRNN + c0 + 4);
                        a8[0] += w0[0] * bflo(uv.x); a8[1] += w0[1] * bfhi(uv.x); a8[2] += w0[2] * bflo(uv.y); a8[3] += w0[3] * bfhi(uv.y);
                        a8[4] += w1[0] * bflo(uv.z); a8[5] += w1[1] * bfhi(uv.z); a8[6] += w1[2] * bflo(uv.w); a8[7] += w1[3] * bfhi(uv.w); } }
                u32x4 o; o.x = cvt_pk_bf16(a8[0], a8[1]); o.y = cvt_pk_bf16(a8[2], a8[3]); o.z = cvt_pk_bf16(a8[4], a8[5]); o.w = cvt_pk_bf16(a8[6], a8[7]);
                *(u32x4*)(UCONV + (size_t)row * DRNN + c0) = o;
            }
        } break;
        case OP_GATES: {
            lru_gates_phase(UCONV, (const bf16_t*)(ws + OFF_W_G), p.lru_bg, p.lru_lam, LAB, lds, c, G, tid);
        } break;
        case OP_SCAN: {
            bf16_t* GATE = ACT; bf16_t* U = ACT + (size_t)MT * DRNN;
            LAS float* SA = (LAS float*)lds; LAS float* SB = SA + 512;
            const size_t PL = (size_t)MT * DRNN;
            for (int item = c; item < 176; item += G) {
                const int b = item / 22, ch = (item - b * 22) * 64 + lane, p0 = wid * 288;
                {
                    float hl = 0.f, sl = 0.f;
                    scan_chunk<false, false>(LAB, LAB + PL, GATE, U, UCONV, b, ch, p0, hl, sl);
                    SA[wid * 64 + lane] = sl; SB[wid * 64 + lane] = hl;
                    __syncthreads();
                    float h = 0.f;
                    for (int k = 0; k < wid; ++k) h = __expf(SA[k * 64 + lane]) * h + SB[k * 64 + lane];
                    __syncthreads();
                    scan_chunk<true, false>(LAB, LAB + PL, GATE, U, UCONV, b, ch, p0, h, sl);
                    __syncthreads();
                }
                {
                    float hl = 0.f, sl = 0.f;
                    scan_chunk<false, true>(LAB + 2 * PL, LAB + 3 * PL, GATE, U, UCONV, b, ch, p0, hl, sl);
                    SA[wid * 64 + lane] = sl; SB[wid * 64 + lane] = hl;
                    __syncthreads();
                    float h = 0.f;
                    for (int k = 0; k < wid; ++k) h = __expf(SA[k * 64 + lane]) * h + SB[k * 64 + lane];
                    __syncthreads();
                    scan_chunk<true, true>(LAB + 2 * PL, LAB + 3 * PL, GATE, U, UCONV, b, ch, p0, h, sl);
                    __syncthreads();
                }
            }
        } break;
        case OP_CONV3: {
            const bf16_t* BG = ACT; const bf16_t* PP = ACT + (size_t)MT * 1024; bf16_t* YIN = ACT + (size_t)2 * MT * 1024;
            for (int it = gtid; it < MT * 128; it += ngt) {
                const int row = it >> 7, c0 = (it & 127) * 8;
                int sq, len; if (row < ML) { sq = row & 2047; len = SEQ; } else { sq = (row - ML) & 255; len = CTXL; }
                float a8[8];
#pragma unroll
                for (int i = 0; i < 8; ++i) a8[i] = 0.f;
#pragma unroll
                for (int k = 0; k < 3; ++k) { const int t = sq + k - 1;
                    if (t >= 0 && t < len) { const u32x4 uv = *(const u32x4*)(PP + (size_t)(row + k - 1) * 1024 + c0);
                        const f32x4 w0 = *(const f32x4*)(p.sc_conv_w + k * 1024 + c0), w1 = *(const f32x4*)(p.sc_conv_w + k * 1024 + c0 + 4);
                        a8[0] += w0[0] * bflo(uv.x); a8[1] += w0[1] * bfhi(uv.x); a8[2] += w0[2] * bflo(uv.y); a8[3] += w0[3] * bfhi(uv.y);
                        a8[4] += w1[0] * bflo(uv.z); a8[5] += w1[1] * bfhi(uv.z); a8[6] += w1[2] * bflo(uv.w); a8[7] += w1[3] * bfhi(uv.w); } }
                const u32x4 bv = *(const u32x4*)(BG + (size_t)row * 1024 + c0);
                u32x4 o; o.x = cvt_pk_bf16(a8[0] * bflo(bv.x), a8[1] * bfhi(bv.x)); o.y = cvt_pk_bf16(a8[2] * bflo(bv.y), a8[3] * bfhi(bv.y));
                o.z = cvt_pk_bf16(a8[4] * bflo(bv.z), a8[5] * bfhi(bv.z)); o.w = cvt_pk_bf16(a8[6] * bflo(bv.w), a8[7] * bfhi(bv.w));
                *(u32x4*)(YIN + (size_t)row * 1024 + c0) = o;
            }
        } break;
        default: break;
        }
        if (dosync) xcd_barrier(xb);
    }
}

extern "C" void kernel_launch(void* const* d_in, const int* in_sizes, int n_in, void* d_out, int out_size, void* d_ws, size_t ws_size, hipStream_t stream) {
    static int grid_blocks = 0;
    if (grid_blocks == 0) {
        if (n_in != 23 || ws_size < WS_END) { fprintf(stderr, "kernel_launch: need 23 inputs and %zu bytes of workspace (got %d, %zu)\n", (size_t)WS_END, n_in, ws_size); grid_blocks = -1; return; }
        int dev = 0, cus = 0, per_cu = 0;
        (void)hipGetDevice(&dev);
        (void)hipDeviceGetAttribute(&cus, hipDeviceAttributeMultiprocessorCount, dev);
        if (hipFuncSetAttribute((const void*)fwd_kernel, hipFuncAttributeMaxDynamicSharedMemorySize, LDS_BYTES) != hipSuccess) { fprintf(stderr, "kernel_launch: hipFuncSetAttribute failed\n"); grid_blocks = -1; return; }
        (void)hipOccupancyMaxActiveBlocksPerMultiprocessor(&per_cu, (const void*)fwd_kernel, 512, LDS_BYTES);
        if (per_cu < 1) { fprintf(stderr, "kernel_launch: occupancy query returned %d\n", per_cu); per_cu = 1; }
        (void)hipGetLastError();
        grid_blocks = cus * per_cu;
    }
    if (grid_blocks < 0) return;
    Params p{};
    const float** pp = (const float**)&p;
    for (int i = 0; i < 23; ++i) pp[i] = (const float*)d_in[i];
    p.out = (float*)d_out; p.ws = (unsigned char*)d_ws;
    void* args[] = {&p};
    hipError_t e = hipLaunchCooperativeKernel((const void*)fwd_kernel, dim3(grid_blocks), dim3(512), args, LDS_BYTES, stream);
    if (e != hipSuccess) fprintf(stderr, "cooperative launch failed: %s (grid %d)\n", hipGetErrorString(e), grid_blocks);
}
```
